# Optimizing an MI355X kernel written in HIP

```python
import math
import jax, jax.numpy as jnp
from jax import lax
import numpy as np

D_MODEL = 2048
BATCH = 4
SEQ = 2048
DEPTH = 1

D_MIX = D_MODEL
HEAD_DIM = 64
D_ATTN = D_MIX // 2
N_Q_HEADS = D_ATTN // HEAD_DIM
N_KV_HEADS = 2
Q_PER_KV = N_Q_HEADS // N_KV_HEADS
D_KV = N_KV_HEADS * HEAD_DIM
WINDOW = 128
BLOCK = WINDOW
D_SGU = D_MIX - D_ATTN
SGU_GROUPS = 8
SGU_GROUP_DIM = D_SGU // SGU_GROUPS
CHUNK = 128
D_IN = D_ATTN + 2 * D_KV + D_ATTN + 3 * D_SGU
EPS = 1e-6

kernel_name = "hybrid_swa_sink_gmlp_parallel_heads"


def rms_norm(x, g):
    xf = x.astype(jnp.float32)
    y = xf * lax.rsqrt(jnp.mean(xf * xf, axis=-1, keepdims=True) + EPS)
    return (y * g.astype(jnp.float32)).astype(x.dtype)


def layer_norm(x, g, b):
    xf = x.astype(jnp.float32)
    mu = jnp.mean(xf, axis=-1, keepdims=True)
    var = jnp.mean(jnp.square(xf - mu), axis=-1, keepdims=True)
    y = (xf - mu) * lax.rsqrt(var + EPS)
    return (y * g.astype(jnp.float32) + b.astype(jnp.float32)).astype(x.dtype)


def sliding_window_sink_attention(q, k, v, sinks):
    B, S = q.shape[0], q.shape[1]
    nb = S // BLOCK
    qb = q.reshape(B, nb, BLOCK, N_KV_HEADS, Q_PER_KV, HEAD_DIM)
    kb = k.reshape(B, nb, BLOCK, N_KV_HEADS, HEAD_DIM)
    vb = v.reshape(B, nb, BLOCK, N_KV_HEADS, HEAD_DIM)
    pad = ((0, 0), (1, 0), (0, 0), (0, 0), (0, 0))
    k_ext = jnp.concatenate([jnp.pad(kb, pad)[:, :-1], kb], axis=2)
    v_ext = jnp.concatenate([jnp.pad(vb, pad)[:, :-1], vb], axis=2)
    scale = 1.0 / math.sqrt(HEAD_DIM)
    scores = jnp.einsum('bnqhgd,bnshd->bnhgqs', qb, k_ext).astype(jnp.float32) * scale
    qpos = jnp.arange(BLOCK)[:, None] + BLOCK
    kpos = jnp.arange(2 * BLOCK)[None, :]
    dist = qpos - kpos
    band = (dist >= 0) & (dist < WINDOW)
    has_prev = (jnp.arange(nb) > 0)[:, None, None] | (kpos >= BLOCK)[None]
    valid = band[None] & has_prev
    scores = jnp.where(valid[None, :, None, None], scores, -jnp.inf)
    sink = sinks.astype(jnp.float32).reshape(N_KV_HEADS, Q_PER_KV)
    sink = jnp.broadcast_to(sink[None, None, :, :, None, None], scores.shape[:-1] + (1,))
    probs = jax.nn.softmax(jnp.concatenate([scores, sink], axis=-1), axis=-1)[..., :-1]
    out = jnp.einsum('bnhgqs,bnshd->bnqhgd', probs.astype(v.dtype), v_ext)
    return out.reshape(B, S, N_Q_HEADS * HEAD_DIM)


def chunked_spatial_gating(u, v, ln_g, ln_b, w_s, b_s):
    B, S = u.shape[0], u.shape[1]
    nc = S // CHUNK
    vn = layer_norm(v, ln_g, ln_b).reshape(B, nc, CHUNK, SGU_GROUPS, SGU_GROUP_DIM)
    causal = jnp.tril(jnp.ones((CHUNK, CHUNK), dtype=w_s.dtype))
    w = w_s * causal[None]
    mixed = jnp.einsum('gts,bnsgc->bntgc', w, vn) + b_s.T[None, None, :, :, None]
    return u * mixed.reshape(B, S, D_SGU)


def setup_inputs(seed: int = 0) -> dict:
    key = jax.random.key(seed)
    ks = jax.random.split(key, 14)
    f32 = jnp.float32
    x = jax.random.normal(ks[0], (BATCH, SEQ, D_MODEL), f32)
    c = jax.random.normal(ks[1], (BATCH, D_MODEL), f32)
    norm_g = 1.0 + 0.05 * jax.random.normal(ks[2], (DEPTH, D_MODEL), f32)
    w_ada = 0.5 * D_MODEL ** -0.5 * jax.random.normal(ks[3], (DEPTH, D_MODEL, 3 * D_MODEL), f32)
    b_ada = 0.02 * jax.random.normal(ks[4], (DEPTH, 3 * D_MODEL), f32)
    w_in = D_MODEL ** -0.5 * jax.random.normal(ks[5], (DEPTH, D_MODEL, D_IN), f32)
    attn_sinks = 0.5 * jax.random.normal(ks[6], (DEPTH, N_Q_HEADS), f32)
    sgu_ln_g = 1.0 + 0.05 * jax.random.normal(ks[7], (DEPTH, D_SGU), f32)
    sgu_ln_b = 0.02 * jax.random.normal(ks[8], (DEPTH, D_SGU), f32)
    sgu_w = CHUNK ** -0.5 * jax.random.normal(ks[9], (DEPTH, SGU_GROUPS, CHUNK, CHUNK), f32)
    sgu_b = 1.0 + 0.1 * jax.random.normal(ks[10], (DEPTH, SGU_GROUPS, CHUNK), f32)
    w_out = D_MIX ** -0.5 * jax.random.normal(ks[11], (DEPTH, D_MIX, D_MODEL), f32)
    final_g = 1.0 + 0.05 * jax.random.normal(ks[12], (D_MODEL,), f32)
    return {"x": x, "c": c, "norm_g": norm_g, "w_ada": w_ada, "b_ada": b_ada,
            "w_in": w_in, "attn_sinks": attn_sinks, "sgu_ln_g": sgu_ln_g,
            "sgu_ln_b": sgu_ln_b, "sgu_w": sgu_w, "sgu_b": sgu_b, "w_out": w_out,
            "final_g": final_g}


def reference(x, c, norm_g, w_ada, b_ada, w_in, attn_sinks, sgu_ln_g, sgu_ln_b,
              sgu_w, sgu_b, w_out, final_g):
    B, S = x.shape[0], x.shape[1]
    splits = np.cumsum([D_ATTN, D_KV, D_KV, D_ATTN, D_SGU, D_SGU])
    c_act = jax.nn.silu(c)
    for l in range(DEPTH):
        mod = c_act @ w_ada[l] + b_ada[l]
        shift, scale, gate = jnp.split(mod, 3, axis=-1)
        h = rms_norm(x, norm_g[l]) * (1.0 + scale[:, None, :]) + shift[:, None, :]
        z = h @ w_in[l]
        q, k, v, g_attn, u, v_s, g_sgu = jnp.split(z, splits, axis=-1)
        attn = sliding_window_sink_attention(
            q.reshape(B, S, N_Q_HEADS, HEAD_DIM),
            k.reshape(B, S, N_KV_HEADS, HEAD_DIM),
            v.reshape(B, S, N_KV_HEADS, HEAD_DIM),
            attn_sinks[l]) * jax.nn.silu(g_attn)
        sgu = chunked_spatial_gating(u, v_s, sgu_ln_g[l], sgu_ln_b[l],
                                     sgu_w[l], sgu_b[l]) * jax.nn.silu(g_sgu)
        y = jnp.concatenate([attn, sgu], axis=-1) @ w_out[l]
        x = x + gate[:, None, :] * y
    return rms_norm(x, final_g)
```

```cpp
#include <hip/hip_runtime.h>
#include <hip/hip_cooperative_groups.h>
#include <cstdio>
#include <cstdint>
namespace cg = cooperative_groups;

#ifndef MK_N_LAUNCHES
#define MK_N_LAUNCHES 1
#endif
#ifndef PROBE_REP
#define PROBE_REP 0
#endif

#define LAS __attribute__((address_space(3)))
typedef unsigned short bf16_t;
typedef short bf16x8 __attribute__((ext_vector_type(8)));
typedef float f32x4 __attribute__((ext_vector_type(4)));
typedef float f32x16 __attribute__((ext_vector_type(16)));
typedef unsigned u32x4 __attribute__((ext_vector_type(4)));
typedef unsigned u32x2 __attribute__((ext_vector_type(2)));

constexpr int NB = 4, SEQ = 2048, DM = 2048, MTOK = NB * SEQ, DIN = 5376;
constexpr int DINZ = 4352;
constexpr int C_Q = 0, C_K = 1024, C_V = 1152, C_GA = 1280, C_VS = 2304, C_UG = 3328;
constexpr float EPS = 1e-6f;
constexpr float LOG2E = 1.4426950408889634f;
constexpr float QSCALE = 0.125f * LOG2E;

constexpr size_t MiB = 1u << 20;
constexpr size_t WS_MOD = 4096;
constexpr size_t WS_ROWSS = 128 * 1024;
constexpr size_t WS_CNT = 176 * 1024;
constexpr size_t WS_Q = 184 * 1024;
constexpr size_t WS_BAR = 192 * 1024;
constexpr size_t WS_STATS = 256 * 1024;
constexpr size_t WS_MODX = 320 * 1024;
constexpr size_t CTL_ZERO_BYTES = 512 * 1024;
constexpr size_t WS_WIN = 2 * MiB;
constexpr size_t WS_WOUT = 24 * MiB;
constexpr size_t WS_SW = 32 * MiB;
constexpr size_t WS_CC = 34 * MiB;
constexpr size_t WS_Z = 66 * MiB;
constexpr size_t WS_END = 150 * MiB;

constexpr int LDS_XB = 141312;
constexpr int LDS_BYTES = LDS_XB + 1024;

__device__ __forceinline__ unsigned cvt_pk_bf16(float lo, float hi) { unsigned r; asm volatile("v_cvt_pk_bf16_f32 %0, %1, %2" : "=v"(r) : "v"(lo), "v"(hi)); return r; }
__device__ __forceinline__ float bf_lo(unsigned u) { return __uint_as_float(u << 16); }
__device__ __forceinline__ float bf_hi(unsigned u) { return __uint_as_float(u & 0xffff0000u); }
__device__ __forceinline__ float wave_sum(float v) {
#pragma unroll
    for (int o = 1; o < 64; o <<= 1) v += __shfl_xor(v, o);
    return v;
}
__device__ __forceinline__ float silu_f(float v) { return v * __builtin_amdgcn_rcpf(1.0f + __builtin_amdgcn_exp2f(-v * LOG2E)); }


#define XB_TMO      128
#define XB_XCNT(j)  (256  + 64 * (j))
#define XB_XSUB(j)  (1280 + 64 * (j))
#define XB_XGEN(j)  (2304 + 64 * (j))
#define XB_TOP      3328
#define XB_TOPGEN   3392
#define XCD_BAR_WORDS 3456
#define XB_SPIN_CAP (1u << 18)
__device__ __forceinline__ unsigned xb_ld(unsigned* p)              { return __hip_atomic_load(p, __ATOMIC_RELAXED, __HIP_MEMORY_SCOPE_AGENT); }
__device__ __forceinline__ unsigned xb_add(unsigned* p, unsigned v) { return __hip_atomic_fetch_add(p, v, __ATOMIC_RELAXED, __HIP_MEMORY_SCOPE_AGENT); }
__device__ __forceinline__ unsigned xb_xcc_id() { return (unsigned)__builtin_amdgcn_s_getreg((3 << 11) | 20) & 0xFu; }
#define XB_SPIN(cond, bar) do { unsigned _sp = 0; while (cond) { __builtin_amdgcn_s_sleep(1); \
    if ((++_sp & 255u) == 0u) { if (xb_ld(&(bar)[XB_TMO])) break; if (_sp > XB_SPIN_CAP) { atomicAdd(&(bar)[XB_TMO], 1u); break; } } } } while (0)
struct XcdBarrier { unsigned* bar; unsigned x; volatile LAS unsigned* st; };
__device__ __forceinline__ XcdBarrier xcd_barrier_post(unsigned* bar, volatile LAS unsigned* st) {
    XcdBarrier b; b.bar = bar; b.x = xb_xcc_id(); b.st = st;
    if (threadIdx.x == 0) (void)xb_add(&bar[XB_XCNT(b.x)], 1u);
    return b;
}
__device__ __forceinline__ void xcd_barrier_complete(unsigned* bar, unsigned x, unsigned& nloc, unsigned& nx) {
    const unsigned G = gridDim.x * gridDim.y * gridDim.z;
    unsigned sum, cnt, mine, sp = 0u;
    for (;;) {
        sum = 0u; cnt = 0u; mine = 0u;
#pragma unroll
        for (unsigned j = 0; j < 16; ++j) { const unsigned c = xb_ld(&bar[XB_XCNT(j)]); sum += c; cnt += (c > 0u) ? 1u : 0u; mine = (j == x) ? c : mine; }
        if (sum == G) break;
        __builtin_amdgcn_s_sleep(1);
        if ((++sp & 255u) == 0u) { if (xb_ld(&bar[XB_TMO])) break; if (sp > XB_SPIN_CAP) { atomicAdd(&bar[XB_TMO], 1u); break; } }
    }
    nloc = mine > 0u ? mine : 1u; nx = cnt > 0u ? cnt : 1u;
}
__device__ __forceinline__ void xcd_barrier(const XcdBarrier& b) {
    asm volatile("s_waitcnt vmcnt(0)" ::: "memory");
    __syncthreads();
    if (threadIdx.x == 0) {
        unsigned* bar = b.bar;
        __builtin_amdgcn_s_waitcnt(0);
        unsigned nloc = b.st[0], nx = b.st[1];
        if (nloc == 0u) { xcd_barrier_complete(bar, b.x, nloc, nx); b.st[0] = nloc; b.st[1] = nx; }
        const unsigned old = xb_add(&bar[XB_XSUB(b.x)], 1u);
        const unsigned gen = old / nloc;
        if (old + 1u == (gen + 1u) * nloc) {
            __builtin_amdgcn_fence(__ATOMIC_RELEASE, "agent");
            asm volatile("s_waitcnt vmcnt(0)" ::: "memory");
            const unsigned og = xb_add(&bar[XB_TOP], 1u);
            const unsigned tg = og / nx;
            if (og + 1u == (tg + 1u) * nx) xb_add(&bar[XB_TOPGEN], 1u);
            else XB_SPIN(xb_ld(&bar[XB_TOPGEN]) == tg, bar);
            __builtin_amdgcn_fence(__ATOMIC_ACQUIRE, "agent");
            xb_add(&bar[XB_XGEN(b.x)], 1u);
            asm volatile("s_waitcnt vmcnt(0)" ::: "memory");
        } else {
            XB_SPIN(xb_ld(&bar[XB_XGEN(b.x)]) == gen, bar);
            __builtin_amdgcn_fence(__ATOMIC_ACQUIRE, "agent");
            asm volatile("s_waitcnt vmcnt(0)" ::: "memory");
        }
    }
    __syncthreads();
}

namespace pg8 {
constexpr int BM = 256, BK = 64, HALF = 128, HTB = HALF * BK * 2, STAGE_BYTES = 8 * HTB, NXCD = 8, WGM = 8;
__host__ __device__ __forceinline__ int lds_byte(int r, int c) { const int st = (r >> 4) * 2 + (c >> 5), rr = r & 15, cc = c & 31, ob = rr * 64 + cc * 2; return st * 1024 + (ob ^ (((ob >> 9) & 1) << 5)); }
__host__ __device__ __forceinline__ void stage_rc(int b, int& R, int& C) { const int st = b / 1024, sb = b % 1024, swz = sb ^ (((sb >> 9) & 1) << 5); R = (st >> 1) * 16 + swz / 64; C = (st & 1) * 32 + (swz % 64) / 2; }
__host__ __device__ __forceinline__ int perm32(int rho) { const int n = rho >> 4, i = rho & 15; return 8 * (i >> 2) + 4 * n + (i & 3); }

struct Unit { int pm, pn; };
struct Gemm { const bf16_t* A; const bf16_t* Bt; int M, N, K; };

struct StaticOrder {
    int nM, nN, nwg, G, c;
    __host__ __device__ void init(int M, int N, int G_, int c_) { nM = M / BM; nN = N / BM; nwg = nM * nN; G = G_; c = c_; }
    __host__ __device__ bool next(int i, Unit& u) const {
        const long L = (long)i * G + c; if (L >= nwg) return false;
        int wgid = (int)L; { const int q = nwg / NXCD, r = nwg % NXCD, xcd = wgid % NXCD, off = wgid / NXCD; wgid = (xcd < r ? xcd * (q + 1) : r * (q + 1) + (xcd - r) * q) + off; }
        const int nig = WGM * nN, gid = wgid / nig, fm = gid * WGM, gsz = (nM - fm) < WGM ? (nM - fm) : WGM;
        u.pm = fm + ((wgid % nig) % gsz); u.pn = (wgid % nig) / gsz; return true;
    }
    __device__ __forceinline__ void a_ready(const Unit&) const {}
    __device__ __forceinline__ void done(const Unit&) const {}
};


struct EpiZ {
    static constexpr bool PERM = true, AFTER_DRAIN = false;
    bf16_t* O; float* stats;
    __device__ __forceinline__ void operator()(const f32x4 (&acc)[2][2][4][2], const Unit& u, int wr, int wc, int fr, int fq) const {
        const int row0 = u.pm * BM + wr * 64 + fr; const int col0 = u.pn * BM + wc * 32 + 8 * fq;
        const int pn = u.pn;
        const int mode = (pn < 4) ? 1 : ((pn >= 5 && pn <= 8) ? 2 : 0);
        if (pn >= 13) {
            const int colz = C_UG + (pn - 13) * 128 + wc * 32 + 8 * fq;
#pragma unroll
            for (int ai = 0; ai < 2; ++ai)
#pragma unroll
                for (int m = 0; m < 4; ++m) { const f32x4 u0 = acc[ai][0][m][0], u1 = acc[ai][0][m][1], g0 = acc[ai][1][m][0], g1 = acc[ai][1][m][1];
                    u32x4 w; w.x = cvt_pk_bf16(u0[0] * silu_f(g0[0]), u0[1] * silu_f(g0[1])); w.y = cvt_pk_bf16(u0[2] * silu_f(g0[2]), u0[3] * silu_f(g0[3]));
                    w.z = cvt_pk_bf16(u1[0] * silu_f(g1[0]), u1[1] * silu_f(g1[1])); w.w = cvt_pk_bf16(u1[2] * silu_f(g1[2]), u1[3] * silu_f(g1[3]));
                    *(u32x4*)(O + (size_t)(row0 + ai * HALF + m * 16) * DINZ + colz) = w; }
            return;
        }
        if (pn >= 9 && pn <= 12) {
#pragma unroll
            for (int ai = 0; ai < 2; ++ai)
#pragma unroll
                for (int m = 0; m < 4; ++m) { float s1 = 0.f, s2 = 0.f;
#pragma unroll
                    for (int bj = 0; bj < 2; ++bj)
#pragma unroll
                        for (int n = 0; n < 2; ++n) { const f32x4 v = acc[ai][bj][m][n]; s1 += (v[0] + v[1]) + (v[2] + v[3]); s2 += (v[0] * v[0] + v[1] * v[1]) + (v[2] * v[2] + v[3] * v[3]); }
                    s1 += __shfl_xor(s1, 16); s1 += __shfl_xor(s1, 32); s2 += __shfl_xor(s2, 16); s2 += __shfl_xor(s2, 32);
                    if (fq == 0) { float* sp = stats + 2 * (size_t)(row0 + ai * HALF + m * 16); atomicAdd(sp, s1); atomicAdd(sp + 1, s2); } }
        }
#pragma unroll
        for (int ai = 0; ai < 2; ++ai)
#pragma unroll
            for (int m = 0; m < 4; ++m) { bf16_t* rowp = O + (size_t)(row0 + ai * HALF + m * 16) * DINZ + col0;
#pragma unroll
                for (int bj = 0; bj < 2; ++bj) { f32x4 v0 = acc[ai][bj][m][0], v1 = acc[ai][bj][m][1];
                    if (mode == 1) { v0 = v0 * QSCALE; v1 = v1 * QSCALE; }
                    else if (mode == 2) {
#pragma unroll
                        for (int j = 0; j < 4; ++j) { v0[j] = silu_f(v0[j]); v1[j] = silu_f(v1[j]); } }
                    u32x4 w; w.x = cvt_pk_bf16(v0[0], v0[1]); w.y = cvt_pk_bf16(v0[2], v0[3]); w.z = cvt_pk_bf16(v1[0], v1[1]); w.w = cvt_pk_bf16(v1[2], v1[3]);
                    *(u32x4*)(rowp + bj * HALF) = w; } }
    }
};

struct EpiOut {
    static constexpr bool PERM = false, AFTER_DRAIN = false;
    const float* x; float* out; const float* gate  ; float* rowss;
    __device__ __forceinline__ void operator()(const f32x4 (&acc)[2][2][4][2], const Unit& u, int wr, int wc, int fr, int fq) const {
        const int row0 = u.pm * BM + wr * 64 + fr; const int col0 = u.pn * BM + wc * 32 + 4 * fq;
        const int b = u.pm >> 3;
        f32x4 gv[2][2];
#pragma unroll
        for (int bj = 0; bj < 2; ++bj)
#pragma unroll
            for (int n = 0; n < 2; ++n) gv[bj][n] = *(const f32x4*)(gate + b * 6144 + col0 + bj * HALF + 16 * n);
#pragma unroll
        for (int ai = 0; ai < 2; ++ai)
#pragma unroll
            for (int m = 0; m < 4; ++m) { const int row = row0 + ai * HALF + m * 16; const size_t ro = (size_t)row * DM + col0; float ss = 0.f;
#pragma unroll
                for (int bj = 0; bj < 2; ++bj)
#pragma unroll
                    for (int n = 0; n < 2; ++n) { const f32x4 xv = *(const f32x4*)(x + ro + bj * HALF + 16 * n); const f32x4 y = xv + gv[bj][n] * acc[ai][bj][m][n];
                        *(f32x4*)(out + ro + bj * HALF + 16 * n) = y; ss += (y[0] * y[0] + y[1] * y[1]) + (y[2] * y[2] + y[3] * y[3]); }
                ss += __shfl_xor(ss, 16); ss += __shfl_xor(ss, 32);
                if (fq == 0) atomicAdd(rowss + row, ss); }
    }
};


struct EpiOutFused {
    static constexpr bool PERM = false, AFTER_DRAIN = true;
    const float* x; float* out; const float* gate; const float* fg; float* rowss; unsigned* cnt;
    __device__ __forceinline__ void fused(f32x4 (&acc)[2][2][4][2], const Unit& u, int wr, int wc, int fr, int fq, LAS unsigned char* lds, int wid, int lane) const {
        LAS float* P = (LAS float*)lds;
        LAS float* S = (LAS float*)(lds + 4096);
        const int rowl0 = wr * 64 + fr; const int col0 = u.pn * BM + wc * 32 + 4 * fq;
        const int b = u.pm >> 3;
        f32x4 gv[2][2];
#pragma unroll
        for (int bj = 0; bj < 2; ++bj)
#pragma unroll
            for (int n = 0; n < 2; ++n) gv[bj][n] = *(const f32x4*)(gate + b * 6144 + col0 + bj * HALF + 16 * n);
#pragma unroll
        for (int ai = 0; ai < 2; ++ai)
#pragma unroll
            for (int m = 0; m < 4; ++m) { const int rowl = rowl0 + ai * HALF + m * 16; const size_t ro = (size_t)(u.pm * BM + rowl) * DM + col0; float ss = 0.f;
#pragma unroll
                for (int bj = 0; bj < 2; ++bj)
#pragma unroll
                    for (int n = 0; n < 2; ++n) { const f32x4 xv = *(const f32x4*)(x + ro + bj * HALF + 16 * n); const f32x4 y = xv + gv[bj][n] * acc[ai][bj][m][n];
                        acc[ai][bj][m][n] = y; ss += (y[0] * y[0] + y[1] * y[1]) + (y[2] * y[2] + y[3] * y[3]); }
                ss += __shfl_xor(ss, 16); ss += __shfl_xor(ss, 32);
                if (fq == 0) P[rowl * 4 + wc] = ss; }
        asm volatile("s_waitcnt lgkmcnt(0)" ::: "memory"); __builtin_amdgcn_s_barrier(); asm volatile("" ::: "memory");
        const int tid = wid * 64 + lane;
        if (tid < 256) { const float t = (P[tid * 4 + 0] + P[tid * 4 + 1]) + (P[tid * 4 + 2] + P[tid * 4 + 3]);
            const float old = __hip_atomic_fetch_add(rowss + u.pm * BM + tid, t, __ATOMIC_RELAXED, __HIP_MEMORY_SCOPE_AGENT); asm volatile("" :: "v"(old)); }
        asm volatile("s_waitcnt vmcnt(0)" ::: "memory"); __builtin_amdgcn_s_barrier(); asm volatile("" ::: "memory");
        if (wid == 0) {
            if (lane == 0) {
                unsigned* c = cnt + 64 * u.pm;
                (void)__hip_atomic_fetch_add(c, 1u, __ATOMIC_RELAXED, __HIP_MEMORY_SCOPE_AGENT);
                unsigned sp = 0;
                while (__hip_atomic_load(c, __ATOMIC_RELAXED, __HIP_MEMORY_SCOPE_AGENT) < 8u) { __builtin_amdgcn_s_sleep(1); if (++sp > (1u << 22)) break; }
            }
            __builtin_amdgcn_fence(__ATOMIC_ACQUIRE, "agent");
        }
        asm volatile("s_waitcnt vmcnt(0) lgkmcnt(0)" ::: "memory"); __builtin_amdgcn_s_barrier(); asm volatile("" ::: "memory");
        if (tid < 256) S[tid] = 1.0f / sqrtf(__hip_atomic_load(rowss + u.pm * BM + tid, __ATOMIC_RELAXED, __HIP_MEMORY_SCOPE_AGENT) * (1.0f / DM) + EPS);
        asm volatile("s_waitcnt vmcnt(0) lgkmcnt(0)" ::: "memory"); __builtin_amdgcn_s_barrier(); asm volatile("" ::: "memory");
        f32x4 fv[2][2];
#pragma unroll
        for (int bj = 0; bj < 2; ++bj)
#pragma unroll
            for (int n = 0; n < 2; ++n) fv[bj][n] = *(const f32x4*)(fg + col0 + bj * HALF + 16 * n);
#pragma unroll
        for (int ai = 0; ai < 2; ++ai)
#pragma unroll
            for (int m = 0; m < 4; ++m) { const int rowl = rowl0 + ai * HALF + m * 16; const size_t ro = (size_t)(u.pm * BM + rowl) * DM + col0; const float rstd = S[rowl];
#pragma unroll
                for (int bj = 0; bj < 2; ++bj)
#pragma unroll
                    for (int n = 0; n < 2; ++n) *(f32x4*)(out + ro + bj * HALF + 16 * n) = acc[ai][bj][m][n] * rstd * fv[bj][n]; }
    }
};

template <class Epi, class Sched, bool ALIGN_EPI = false, bool SP2 = false>
__device__ __forceinline__ void gemm_phase(LAS unsigned char* lds, const Gemm g, const Sched& S, const Epi& E) {
    const int tid = threadIdx.x, wid = __builtin_amdgcn_readfirstlane(tid >> 6), lane = tid & 63, wr = wid >> 2, wc = wid & 3, fr = lane & 15, fq = lane >> 4;
    const int K = g.K, nt = K / BK;
    unsigned voffA[2], voffB[2];
#pragma unroll
    for (int i = 0; i < 2; ++i) { int R, C; stage_rc(tid * 16 + i * 8192, R, C); const int Rb = Epi::PERM ? ((R & ~31) + perm32(R & 31)) : R;
        voffA[i] = (unsigned)(R * K + C) * 2u; voffB[i] = (unsigned)(Rb * K + C) * 2u; }
    const size_t kstep = (size_t)(BK * 2);
    const size_t hstep = (size_t)HALF * K * 2;
    const size_t tstep = 2 * hstep;
    const unsigned ldsw = (unsigned)wid * 1024u;
    const int aoff = lds_byte(wr * 64 + fr, fq * 8), boff = lds_byte(wc * 32 + fr, fq * 8);
#define PG8_SA(b, h) (((b) * 2 + (h)) * HTB)
#define PG8_SB(b, h) ((4 + (b) * 2 + (h)) * HTB)
#define PG8_STAGE(bufoff, gbase, voff) do { _Pragma("unroll") for (int _i = 0; _i < 2; ++_i) \
        __builtin_amdgcn_global_load_lds((const unsigned*)((const char*)(gbase) + (voff)[_i]), (LAS unsigned*)(lds + (bufoff) + ldsw + _i * 8192), 16, 0, 0); } while (0)
#define PG8_LDA(dst, b, h) do { _Pragma("unroll") for (int m = 0; m < 4; ++m) _Pragma("unroll") for (int k = 0; k < 2; ++k) dst[m][k] = *(const LAS bf16x8*)(lds + PG8_SA(b, h) + aoff + m * 2048 + k * 1024); } while (0)
#define PG8_LDB(dst, b, h) do { _Pragma("unroll") for (int n = 0; n < 2; ++n) _Pragma("unroll") for (int k = 0; k < 2; ++k) dst[n][k] = *(const LAS bf16x8*)(lds + PG8_SB(b, h) + boff + n * 2048 + k * 1024); } while (0)
#define PG8_MMA(ai, bj, At, Bt) do { __builtin_amdgcn_s_setprio(1); _Pragma("unroll") for (int m = 0; m < 4; ++m) _Pragma("unroll") for (int n = 0; n < 2; ++n) _Pragma("unroll") for (int k = 0; k < 2; ++k) \
        acc[ai][bj][m][n] = __builtin_amdgcn_mfma_f32_16x16x32_bf16(Bt[n][k], At[m][k], acc[ai][bj][m][n], 0, 0, 0); __builtin_amdgcn_s_setprio(0); } while (0)
#define PG8_WAIT_V(n) asm volatile("s_waitcnt vmcnt(" #n ")" ::: "memory")
#define PG8_WAIT_L(n) asm volatile("s_waitcnt lgkmcnt(" #n ")" ::: "memory")
#define PG8_BAR __builtin_amdgcn_s_barrier()
#define PG8_SCHED __builtin_amdgcn_sched_barrier(0)
    Unit cur, nxt; int ui = 0;
    if (!S.next(0, cur)) return;
    f32x4 acc[2][2][4][2];
#pragma unroll
    for (int a = 0; a < 2; ++a)
#pragma unroll
        for (int b = 0; b < 2; ++b)
#pragma unroll
            for (int m = 0; m < 4; ++m)
#pragma unroll
                for (int n = 0; n < 2; ++n) acc[a][b][m][n] = (f32x4){0.f, 0.f, 0.f, 0.f};
    bf16x8 At[4][2], B0[2][2], B1[2][2];
    const char* cA = (const char*)g.A + (size_t)cur.pm * tstep; const char* cB = (const char*)g.Bt + (size_t)cur.pn * tstep;
    S.a_ready(cur);
    if constexpr (SP2) {
        PG8_STAGE(PG8_SB(0, 0), cB, voffB); PG8_STAGE(PG8_SB(0, 1), cB + hstep, voffB); PG8_STAGE(PG8_SA(0, 0), cA, voffA); PG8_STAGE(PG8_SA(0, 1), cA + hstep, voffA);
        if (wr == 1) PG8_BAR;
        PG8_WAIT_V(2); PG8_BAR;
        PG8_STAGE(PG8_SB(1, 0), cB + kstep, voffB); PG8_STAGE(PG8_SA(1, 0), cA + kstep, voffA); PG8_STAGE(PG8_SB(1, 1), cB + hstep + kstep, voffB);
        PG8_WAIT_V(6); PG8_BAR;
    } else {
        PG8_STAGE(PG8_SB(0, 0), cB, voffB); PG8_STAGE(PG8_SA(0, 0), cA, voffA); PG8_STAGE(PG8_SB(0, 1), cB + hstep, voffB); PG8_STAGE(PG8_SA(0, 1), cA + hstep, voffA);
        if (wr == 1) PG8_BAR;
        PG8_WAIT_V(4); PG8_BAR;
        PG8_STAGE(PG8_SB(1, 0), cB + kstep, voffB); PG8_STAGE(PG8_SA(1, 0), cA + kstep, voffA); PG8_STAGE(PG8_SB(1, 1), cB + hstep + kstep, voffB);
        PG8_WAIT_V(6); PG8_BAR;
    }
    for (;;) {
        const bool has_next = S.next(ui + 1, nxt);
        const char* nA = has_next ? (const char*)g.A + (size_t)nxt.pm * tstep : cA; const char* nB = has_next ? (const char*)g.Bt + (size_t)nxt.pn * tstep : cB;
        for (int t = 0; t < nt; t += 2) {
            const bool last = (t == nt - 2);
            const char* a1 = cA + (size_t)(t + 1) * kstep;
            const char* a2 = last ? nA : cA + (size_t)(t + 2) * kstep; const char* b2 = last ? nB : cB + (size_t)(t + 2) * kstep;
            const char* a3 = a2 + kstep; const char* b3 = b2 + kstep;
            if (last && has_next) S.a_ready(nxt);
            if constexpr (SP2) {
            PG8_LDB(B0, 0, 0); PG8_LDB(B1, 0, 1); PG8_SCHED; PG8_LDA(At, 0, 0); PG8_STAGE(PG8_SA(1, 1), a1 + hstep, voffA);
            PG8_WAIT_V(8); PG8_WAIT_L(0); PG8_BAR; PG8_MMA(0, 0, At, B0); PG8_MMA(0, 1, At, B1); PG8_BAR; PG8_SCHED;
            PG8_LDA(At, 0, 1); PG8_STAGE(PG8_SB(0, 0), b2, voffB); PG8_STAGE(PG8_SB(0, 1), b2 + hstep, voffB); PG8_STAGE(PG8_SA(0, 0), a2, voffA);
            PG8_WAIT_V(8); PG8_WAIT_L(0); PG8_BAR; PG8_MMA(1, 0, At, B0); PG8_MMA(1, 1, At, B1); PG8_BAR; PG8_SCHED;
            PG8_LDB(B0, 1, 0); PG8_LDB(B1, 1, 1); PG8_SCHED; PG8_LDA(At, 1, 0); PG8_STAGE(PG8_SA(0, 1), a2 + hstep, voffA);
            PG8_WAIT_V(8); PG8_WAIT_L(0); PG8_BAR; PG8_MMA(0, 0, At, B0); PG8_MMA(0, 1, At, B1); PG8_BAR; PG8_SCHED;
            PG8_LDA(At, 1, 1); PG8_STAGE(PG8_SB(1, 0), b3, voffB); PG8_STAGE(PG8_SB(1, 1), b3 + hstep, voffB); PG8_STAGE(PG8_SA(1, 0), a3, voffA);
            PG8_WAIT_V(8); PG8_WAIT_L(0); PG8_BAR; PG8_MMA(1, 0, At, B0); PG8_MMA(1, 1, At, B1); PG8_BAR; PG8_SCHED;
            } else {
            PG8_LDB(B0, 0, 0); PG8_SCHED; PG8_LDA(At, 0, 0); PG8_STAGE(PG8_SA(1, 1), a1 + hstep, voffA);
            PG8_WAIT_L(8); PG8_BAR; PG8_WAIT_L(0); PG8_MMA(0, 0, At, B0); PG8_BAR; PG8_SCHED;
            PG8_LDB(B1, 0, 1); PG8_STAGE(PG8_SB(0, 0), b2, voffB);
            PG8_BAR; PG8_WAIT_L(0); PG8_MMA(0, 1, At, B1); PG8_BAR;
            PG8_LDA(At, 0, 1); PG8_STAGE(PG8_SA(0, 0), a2, voffA);
            PG8_BAR; PG8_WAIT_L(0); PG8_MMA(1, 0, At, B0); PG8_BAR; PG8_SCHED;
            PG8_STAGE(PG8_SB(0, 1), b2 + hstep, voffB);
            PG8_WAIT_V(6); PG8_BAR; PG8_MMA(1, 1, At, B1); PG8_BAR;
            PG8_LDB(B0, 1, 0); PG8_SCHED; PG8_LDA(At, 1, 0); PG8_STAGE(PG8_SA(0, 1), a2 + hstep, voffA);
            PG8_WAIT_L(8); PG8_BAR; PG8_WAIT_L(0); PG8_MMA(0, 0, At, B0); PG8_BAR; PG8_SCHED;
            PG8_LDB(B1, 1, 1); PG8_STAGE(PG8_SB(1, 0), b3, voffB);
            PG8_BAR; PG8_WAIT_L(0); PG8_MMA(0, 1, At, B1); PG8_BAR;
            PG8_LDA(At, 1, 1); PG8_STAGE(PG8_SA(1, 0), a3, voffA);
            PG8_BAR; PG8_WAIT_L(0); PG8_MMA(1, 0, At, B0); PG8_BAR; PG8_SCHED;
            PG8_STAGE(PG8_SB(1, 1), b3 + hstep, voffB);
            PG8_WAIT_V(6); PG8_BAR; PG8_MMA(1, 1, At, B1); PG8_BAR;
            }
        }
        if constexpr (ALIGN_EPI) { if (wr == 0) PG8_BAR; }
        if constexpr (!Epi::AFTER_DRAIN) { E(acc, cur, wr, wc, fr, fq); S.done(cur); }
        if (!has_next) break;
#pragma unroll
        for (int a = 0; a < 2; ++a)
#pragma unroll
            for (int b = 0; b < 2; ++b)
#pragma unroll
                for (int m = 0; m < 4; ++m)
#pragma unroll
                    for (int n = 0; n < 2; ++n) acc[a][b][m][n] = (f32x4){0.f, 0.f, 0.f, 0.f};
        cur = nxt; cA = nA; cB = nB; ++ui;
        if constexpr (ALIGN_EPI) { if (wr == 1) PG8_BAR; }
    }
    PG8_WAIT_V(0);
    if constexpr (!ALIGN_EPI) { if (wr == 0) PG8_BAR; }
    PG8_BAR;
    if constexpr (Epi::AFTER_DRAIN) { E.fused(acc, cur, wr, wc, fr, fq, lds, wid, lane); S.done(cur); }
#undef PG8_SA
#undef PG8_SB
#undef PG8_STAGE
#undef PG8_LDA
#undef PG8_LDB
#undef PG8_MMA
#undef PG8_WAIT_V
#undef PG8_WAIT_L
#undef PG8_BAR
#undef PG8_SCHED
}
}

#ifndef PG8_SP2
#define PG8_SP2 true
#endif
#ifndef PG8_ALIGN
#define PG8_ALIGN true
#endif

struct Args {
    const float* x; const float* c; const float* norm_g; const float* w_ada; const float* b_ada; const float* w_in; const float* sinks;
    const float* ln_g; const float* ln_b; const float* sgu_w; const float* sgu_b; const float* w_out; const float* final_g;
    float* out; unsigned char* ws; int ph_lo, ph_hi, coop, pad;
};

template <bool PERM_IN>
__device__ __forceinline__ void p0_transpose_wg(const float* W, int K, int N, bf16_t* WT, LAS float* scr, int item, int tid) {
    const int nblk = N / 128, kb = item / nblk, nb = item % nblk, k0 = 128 * kb, n0 = 128 * nb;
    int nd = n0;
    if (PERM_IN) { const int ob = nb; const int nbk = ob < 18 ? ob : (ob < 26 ? 26 + 2 * (ob - 18) : (ob < 34 ? ob - 8 : 27 + 2 * (ob - 34))); nd = 128 * nbk; }
    f32x4 v[8];
#pragma unroll
    for (int i = 0; i < 8; ++i) { const int idx = tid + 512 * i, k = idx >> 5, c4 = idx & 31; v[i] = *(const f32x4*)(W + (size_t)(k0 + k) * N + n0 + 4 * c4); }
#pragma unroll
    for (int i = 0; i < 8; ++i) { const int idx = tid + 512 * i, k = idx >> 5, c4 = idx & 31; *(LAS f32x4*)(scr + k * 132 + 4 * c4) = v[i]; }
    __syncthreads();
#pragma unroll
    for (int i = 0; i < 4; ++i) { const int q = tid + 512 * i, n = q & 127, c = q >> 7; const LAS float* s = scr + (8 * c) * 132 + n;
        u32x4 o; o.x = cvt_pk_bf16(s[0 * 132], s[1 * 132]); o.y = cvt_pk_bf16(s[2 * 132], s[3 * 132]); o.z = cvt_pk_bf16(s[4 * 132], s[5 * 132]); o.w = cvt_pk_bf16(s[6 * 132], s[7 * 132]);
        *(u32x4*)(WT + (size_t)(nd + n) * K + k0 + 8 * c) = o; }
    __syncthreads();
}
__device__ __forceinline__ void p0_gemv_item(const Args& a, float* mod, int item, int lane, unsigned* done = nullptr, int mstride = 6144) {
    const int kc = item / 24, nc = item % 24; const int k0 = kc * 32, n0 = nc * 256 + lane * 4;
    const int kl = k0 + (lane & 31);
    const int cs0 = __float_as_int(silu_f(a.c[0 * DM + kl])), cs1 = __float_as_int(silu_f(a.c[1 * DM + kl])), cs2 = __float_as_int(silu_f(a.c[2 * DM + kl])), cs3 = __float_as_int(silu_f(a.c[3 * DM + kl]));
    f32x4 acc0 = {0.f, 0.f, 0.f, 0.f}, acc1 = acc0, acc2 = acc0, acc3 = acc0;
    const float* wp = a.w_ada + (size_t)k0 * 6144 + n0;
    f32x4 w[32];
#pragma unroll
    for (int k = 0; k < 32; ++k) w[k] = *(const f32x4*)(wp + (size_t)k * 6144);
    __builtin_amdgcn_sched_barrier(0);
#pragma unroll
    for (int k = 0; k < 32; ++k) {
        const float c0 = __int_as_float(__builtin_amdgcn_readlane(cs0, k)), c1 = __int_as_float(__builtin_amdgcn_readlane(cs1, k)), c2 = __int_as_float(__builtin_amdgcn_readlane(cs2, k)), c3 = __int_as_float(__builtin_amdgcn_readlane(cs3, k));
        acc0 += w[k] * c0; acc1 += w[k] * c1; acc2 += w[k] * c2; acc3 += w[k] * c3;
    }
    if (kc == 0) { const f32x4 bb = *(const f32x4*)(a.b_ada + n0); acc0 += bb; acc1 += bb; acc2 += bb; acc3 += bb; }
#pragma unroll
    for (int j = 0; j < 4; ++j) { atomicAdd(mod + 0 * mstride + n0 + j, acc0[j]); atomicAdd(mod + 1 * mstride + n0 + j, acc1[j]); atomicAdd(mod + 2 * mstride + n0 + j, acc2[j]); atomicAdd(mod + 3 * mstride + n0 + j, acc3[j]); }
    if (done) {
        float z = 0.f; asm volatile("" : "+v"(z));
        const float r0 = __hip_atomic_fetch_add(mod + 0 * mstride + n0 + 3, z, __ATOMIC_RELAXED, __HIP_MEMORY_SCOPE_AGENT), r1 = __hip_atomic_fetch_add(mod + 1 * mstride + n0 + 3, z, __ATOMIC_RELAXED, __HIP_MEMORY_SCOPE_AGENT);
        const float r2 = __hip_atomic_fetch_add(mod + 2 * mstride + n0 + 3, z, __ATOMIC_RELAXED, __HIP_MEMORY_SCOPE_AGENT), r3 = __hip_atomic_fetch_add(mod + 3 * mstride + n0 + 3, z, __ATOMIC_RELAXED, __HIP_MEMORY_SCOPE_AGENT);
        asm volatile("" :: "v"(r0), "v"(r1), "v"(r2), "v"(r3));
        asm volatile("s_waitcnt vmcnt(0)" ::: "memory");
        if (lane == 0) (void)__hip_atomic_fetch_add(done, 1u, __ATOMIC_RELAXED, __HIP_MEMORY_SCOPE_AGENT);
    }
}

constexpr int KPITCH = 144, VPITCH = 520, OPITCH = 144;
constexpr int ATT_K = 0, ATT_V = 256 * KPITCH, ATT_O = ATT_V + 64 * VPITCH;
__device__ __forceinline__ void attn_unit(LAS unsigned char* lds, int unit, const bf16_t* Z, bf16_t* CC, const float* sinks, int tid, int wid, int lane) {
    const int hh = unit & 1, kvh = (unit >> 1) & 1, nb = (unit >> 2) & 15, b = unit >> 6;
    const int tok0 = b * SEQ + nb * 128;
    const __amdgpu_buffer_rsrc_t ccr = __builtin_amdgcn_make_buffer_rsrc((void*)CC, 0, MTOK * DM * 2, 0x00020000);
    LAS unsigned char* Kl = lds + ATT_K;
    LAS unsigned char* Vt = lds + ATT_V;
    LAS unsigned char* Ow = lds + ATT_O + wid * (32 * OPITCH);
    const int r = lane & 31, h = lane >> 5;
#pragma unroll
    for (int i = 0; i < 4; ++i) {
        const int ch = tid + 512 * i, key = ch >> 3, c8 = ch & 7;
        const bool valid = (nb > 0) || (key >= 128);
        u32x4 kv = {0u, 0u, 0u, 0u}, vv = {0u, 0u, 0u, 0u};
        if (valid) { const bf16_t* row = Z + (size_t)(tok0 - 128 + key) * DINZ + kvh * 64 + c8 * 8; kv = *(const u32x4*)(row + C_K); vv = *(const u32x4*)(row + C_V); }
        *(LAS u32x4*)(Kl + key * KPITCH + c8 * 16) = kv;
        LAS bf16_t* vt = (LAS bf16_t*)(Vt + (c8 * 8) * VPITCH + key * 2);
        vt[0 * (VPITCH / 2)] = (bf16_t)(vv.x & 0xffffu); vt[1 * (VPITCH / 2)] = (bf16_t)(vv.x >> 16);
        vt[2 * (VPITCH / 2)] = (bf16_t)(vv.y & 0xffffu); vt[3 * (VPITCH / 2)] = (bf16_t)(vv.y >> 16);
        vt[4 * (VPITCH / 2)] = (bf16_t)(vv.z & 0xffffu); vt[5 * (VPITCH / 2)] = (bf16_t)(vv.z >> 16);
        vt[6 * (VPITCH / 2)] = (bf16_t)(vv.w & 0xffffu); vt[7 * (VPITCH / 2)] = (bf16_t)(vv.w >> 16);
    }
    __syncthreads();
#pragma unroll 1
    for (int pi = 0; pi < 2; ++pi) {
        const int p = wid * 2 + pi, hl = p >> 2, qb = p & 3;
        const int head = kvh * 8 + hh * 4 + hl;
        bf16x8 qf[4]; u32x4 gt[4];
        { const bf16_t* qrow = Z + (size_t)(tok0 + qb * 32 + r) * DINZ + C_Q + head * 64 + 8 * h;
#pragma unroll
          for (int ks = 0; ks < 4; ++ks) qf[ks] = *(const bf16x8*)(qrow + 16 * ks);
#pragma unroll
          for (int j = 0; j < 4; ++j) { const int idx = lane + 64 * j, row = idx >> 3, ch = idx & 7;
              gt[j] = *(const u32x4*)(Z + (size_t)(tok0 + qb * 32 + row) * DINZ + C_GA + head * 64 + ch * 8); } }
        f32x16 S[5];
#pragma unroll
        for (int kbi = 0; kbi < 5; ++kbi) {
            const float binit = 0.f; const bool bvalid = ((nb > 0) || (qb + kbi >= 4));
#pragma unroll
            for (int i = 0; i < 16; ++i) S[kbi][i] = binit;
            const LAS unsigned char* kp = Kl + (32 * (qb + kbi) + r) * KPITCH + 16 * h;
#pragma unroll
            for (int ks = 0; ks < 4; ++ks) { const bf16x8 kf = *(const LAS bf16x8*)(kp + 32 * ks); S[kbi] = __builtin_amdgcn_mfma_f32_32x32x16_bf16(kf, qf[ks], S[kbi], 0, 0, 0); }
            if (!bvalid) {
#pragma unroll
                for (int i = 0; i < 16; ++i) S[kbi][i] = -1.0e30f; }
        }
        const float sink_l2 = sinks[head] * LOG2E;
        float mx = sink_l2;
        int tq = r - 4 * h; asm volatile("" : "+v"(tq));
#pragma unroll
        for (int i = 0; i < 16; ++i) { const int cst = (i & 3) + 8 * (i >> 2);
            S[0][i] = (tq >= cst) ? -1.0e30f : S[0][i]; S[4][i] = (tq < cst) ? -1.0e30f : S[4][i]; }
#pragma unroll
        for (int kbi = 0; kbi < 5; ++kbi)
#pragma unroll
            for (int i = 0; i < 16; ++i) mx = fmaxf(mx, S[kbi][i]);
        mx = fmaxf(mx, __shfl_xor(mx, 32));
        typedef float f32x2 __attribute__((ext_vector_type(2)));
        f32x2 lv = {0.f, 0.f}; const f32x2 mxv = {mx, mx};
#pragma unroll
        for (int kbi = 0; kbi < 5; ++kbi)
#pragma unroll
            for (int i = 0; i < 16; i += 2) { const f32x2 d = (f32x2){S[kbi][i], S[kbi][i + 1]} - mxv;
                f32x2 pv; pv.x = __builtin_amdgcn_exp2f(d.x); pv.y = __builtin_amdgcn_exp2f(d.y); S[kbi][i] = pv.x; S[kbi][i + 1] = pv.y; lv += pv; }
        float l = lv.x + lv.y;
        l += __shfl_xor(l, 32);
        l += __builtin_amdgcn_exp2f(sink_l2 - mx);
        f32x16 O[2];
#pragma unroll
        for (int db = 0; db < 2; ++db)
#pragma unroll
            for (int i = 0; i < 16; ++i) O[db][i] = 0.f;
#pragma unroll
        for (int kbi = 0; kbi < 5; ++kbi)
#pragma unroll
            for (int sh = 0; sh < 2; ++sh) {
                u32x4 pw; pw.x = cvt_pk_bf16(S[kbi][8 * sh + 0], S[kbi][8 * sh + 1]); pw.y = cvt_pk_bf16(S[kbi][8 * sh + 2], S[kbi][8 * sh + 3]);
                pw.z = cvt_pk_bf16(S[kbi][8 * sh + 4], S[kbi][8 * sh + 5]); pw.w = cvt_pk_bf16(S[kbi][8 * sh + 6], S[kbi][8 * sh + 7]);
                const bf16x8 pf = __builtin_bit_cast(bf16x8, pw);
#pragma unroll
                for (int db = 0; db < 2; ++db) {
                    const LAS unsigned char* vp = Vt + (32 * db + r) * VPITCH + (32 * (qb + kbi) + 16 * sh + 4 * h) * 2;
                    const u32x2 lo = *(const LAS u32x2*)vp, hi = *(const LAS u32x2*)(vp + 16);
                    u32x4 vw; vw.x = lo.x; vw.y = lo.y; vw.z = hi.x; vw.w = hi.y;
                    O[db] = __builtin_amdgcn_mfma_f32_32x32x16_bf16(__builtin_bit_cast(bf16x8, vw), pf, O[db], 0, 0, 0);
                }
            }
        const float inv = 1.0f / l;
#pragma unroll
        for (int db = 0; db < 2; ++db)
#pragma unroll
            for (int q4 = 0; q4 < 4; ++q4) {
                u32x2 ow; ow.x = cvt_pk_bf16(O[db][4 * q4 + 0] * inv, O[db][4 * q4 + 1] * inv); ow.y = cvt_pk_bf16(O[db][4 * q4 + 2] * inv, O[db][4 * q4 + 3] * inv);
                *(LAS u32x2*)(Ow + r * OPITCH + (32 * db + 8 * q4 + 4 * h) * 2) = ow;
            }
        asm volatile("s_waitcnt lgkmcnt(0)" ::: "memory");
#pragma unroll
        for (int j = 0; j < 4; ++j) { const int idx = lane + 64 * j, row = idx >> 3, ch = idx & 7;
            const u32x4 ov = *(const LAS u32x4*)(Ow + row * OPITCH + ch * 16); const u32x4 gg = gt[j];
            u32x4 w;
            w.x = cvt_pk_bf16(bf_lo(ov.x) * bf_lo(gg.x), bf_hi(ov.x) * bf_hi(gg.x)); w.y = cvt_pk_bf16(bf_lo(ov.y) * bf_lo(gg.y), bf_hi(ov.y) * bf_hi(gg.y));
            w.z = cvt_pk_bf16(bf_lo(ov.z) * bf_lo(gg.z), bf_hi(ov.z) * bf_hi(gg.z)); w.w = cvt_pk_bf16(bf_lo(ov.w) * bf_lo(gg.w), bf_hi(ov.w) * bf_hi(gg.w));
            __builtin_amdgcn_raw_buffer_store_b128(w, ccr, (unsigned)(((tok0 + qb * 32 + row) * DM + head * 64 + ch * 8) * 2), 0, 16); }
        asm volatile("s_waitcnt lgkmcnt(0)" ::: "memory");
    }
    __syncthreads();
}

constexpr int NPITCH = 272, MPITCH = 528;
constexpr int SGU_VN = 0, SGU_MT = 2 * 128 * NPITCH;
__device__ __forceinline__ void sgu_unit(LAS unsigned char* lds, int unit, const bf16_t* Z, bf16_t* CC, const bf16_t* SW, const float* stats, const float* ln_g, const float* ln_b, const float* sgu_b, int tid, int wid, int lane) {
    const int gp = unit & 3, chunk = (unit >> 2) & 15, b = unit >> 6;
    const int tok0 = b * SEQ + chunk * 128;
    const __amdgpu_buffer_rsrc_t ccr = __builtin_amdgcn_make_buffer_rsrc((void*)CC, 0, MTOK * DM * 2, 0x00020000);
    LAS unsigned char* VN = lds + SGU_VN;
    LAS unsigned char* Mt = lds + SGU_MT;
    {
        u32x4 vv[8]; float mean[4], rstd[4];
#pragma unroll
        for (int i = 0; i < 8; ++i) { const int ch = tid + 512 * i, g2 = ch >> 11, s = (ch >> 4) & 127, c8 = ch & 15;
            vv[i] = *(const u32x4*)(Z + (size_t)(tok0 + s) * DINZ + C_VS + (2 * gp + g2) * 128 + c8 * 8); }
#pragma unroll
        for (int i = 0; i < 4; ++i) { const int s = ((tid + 512 * i) >> 4) & 127; const float s1 = stats[2 * (tok0 + s)], s2 = stats[2 * (tok0 + s) + 1];
            mean[i] = s1 * (1.0f / 1024.0f); rstd[i] = 1.0f / sqrtf(fmaxf(s2 * (1.0f / 1024.0f) - mean[i] * mean[i], 0.f) + EPS); }
#pragma unroll
        for (int i = 0; i < 8; ++i) {
            const int ch = tid + 512 * i, g2 = ch >> 11, s = (ch >> 4) & 127, c8 = ch & 15, g = 2 * gp + g2;
            const float mu = mean[i & 3], rs = rstd[i & 3];
            const f32x4 g0 = *(const f32x4*)(ln_g + g * 128 + c8 * 8), g1 = *(const f32x4*)(ln_g + g * 128 + c8 * 8 + 4);
            const f32x4 b0 = *(const f32x4*)(ln_b + g * 128 + c8 * 8), b1 = *(const f32x4*)(ln_b + g * 128 + c8 * 8 + 4);
            LAS bf16_t* vt = (LAS bf16_t*)(VN + g2 * 128 * NPITCH + (c8 * 8) * NPITCH + ((((s >> 3) ^ c8) & 15) << 4) + (s & 7) * 2);
            const u32x4 v = vv[i];
            const float y0 = (bf_lo(v.x) - mu) * rs * g0[0] + b0[0], y1 = (bf_hi(v.x) - mu) * rs * g0[1] + b0[1];
            const float y2 = (bf_lo(v.y) - mu) * rs * g0[2] + b0[2], y3 = (bf_hi(v.y) - mu) * rs * g0[3] + b0[3];
            const float y4 = (bf_lo(v.z) - mu) * rs * g1[0] + b1[0], y5 = (bf_hi(v.z) - mu) * rs * g1[1] + b1[1];
            const float y6 = (bf_lo(v.w) - mu) * rs * g1[2] + b1[2], y7 = (bf_hi(v.w) - mu) * rs * g1[3] + b1[3];
            const unsigned p0 = cvt_pk_bf16(y0, y1), p1 = cvt_pk_bf16(y2, y3), p2 = cvt_pk_bf16(y4, y5), p3 = cvt_pk_bf16(y6, y7);
            vt[0 * (NPITCH / 2)] = (bf16_t)(p0 & 0xffffu); vt[1 * (NPITCH / 2)] = (bf16_t)(p0 >> 16);
            vt[2 * (NPITCH / 2)] = (bf16_t)(p1 & 0xffffu); vt[3 * (NPITCH / 2)] = (bf16_t)(p1 >> 16);
            vt[4 * (NPITCH / 2)] = (bf16_t)(p2 & 0xffffu); vt[5 * (NPITCH / 2)] = (bf16_t)(p2 >> 16);
            vt[6 * (NPITCH / 2)] = (bf16_t)(p3 & 0xffffu); vt[7 * (NPITCH / 2)] = (bf16_t)(p3 >> 16);
        }
    }
    u32x4 ug[8];
#pragma unroll
    for (int i = 0; i < 8; ++i) { const int q = tid + 512 * i, t = q >> 5, c8 = q & 31; ug[i] = *(const u32x4*)(Z + (size_t)(tok0 + t) * DINZ + C_UG + gp * 256 + c8 * 8); }
    __syncthreads();
    {
        const int r = lane & 31, h = lane >> 5;
        const int g2 = wid >> 2, cb = wid & 3, g = 2 * gp + g2;
        bf16x8 af[8];
        { const LAS unsigned char* ap = VN + g2 * 128 * NPITCH + (32 * cb + r) * NPITCH; const int c8r = (4 * cb + (r >> 3)) & 15;
#pragma unroll
          for (int ks = 0; ks < 8; ++ks) af[ks] = *(const LAS bf16x8*)(ap + ((((2 * ks + h) ^ c8r) & 15) << 4)); }
#pragma unroll
        for (int tb = 0; tb < 4; ++tb) {
            f32x16 acc;
#pragma unroll
            for (int i = 0; i < 16; ++i) acc[i] = 0.f;
            const int t = 32 * tb + r;
            const bf16_t* wrow = SW + (size_t)(g * 128 + t) * 128 + 8 * h;
#pragma unroll
            for (int ks = 0; ks < 2 * tb + 2; ++ks) { const bf16x8 wf = *(const bf16x8*)(wrow + 16 * ks); acc = __builtin_amdgcn_mfma_f32_32x32x16_bf16(af[ks], wf, acc, 0, 0, 0); }
            const float bias = sgu_b[g * 128 + t];
#pragma unroll
            for (int q4 = 0; q4 < 4; ++q4) {
                u32x2 ow; ow.x = cvt_pk_bf16(acc[4 * q4 + 0] + bias, acc[4 * q4 + 1] + bias); ow.y = cvt_pk_bf16(acc[4 * q4 + 2] + bias, acc[4 * q4 + 3] + bias);
                *(LAS u32x2*)(Mt + t * MPITCH + (g2 * 128 + 32 * cb + 8 * q4 + 4 * h) * 2) = ow;
            }
        }
    }
    __syncthreads();
#pragma unroll
    for (int i = 0; i < 8; ++i) { const int q = tid + 512 * i, t = q >> 5, c8 = q & 31;
        const u32x4 mv = *(const LAS u32x4*)(Mt + t * MPITCH + c8 * 16); const u32x4 u4 = ug[i];
        u32x4 w;
        w.x = cvt_pk_bf16(bf_lo(u4.x) * bf_lo(mv.x), bf_hi(u4.x) * bf_hi(mv.x));
        w.y = cvt_pk_bf16(bf_lo(u4.y) * bf_lo(mv.y), bf_hi(u4.y) * bf_hi(mv.y));
        w.z = cvt_pk_bf16(bf_lo(u4.z) * bf_lo(mv.z), bf_hi(u4.z) * bf_hi(mv.z));
        w.w = cvt_pk_bf16(bf_lo(u4.w) * bf_lo(mv.w), bf_hi(u4.w) * bf_hi(mv.w));
        __builtin_amdgcn_raw_buffer_store_b128(w, ccr, (unsigned)(((tok0 + t) * DM + 1024 + gp * 256 + c8 * 8) * 2), 0, 16); }
    __syncthreads();
}

__global__ void __launch_bounds__(512, 2) fwd_megakernel(Args a) {
    extern __shared__ __attribute__((aligned(16))) unsigned char lds_raw[];
    LAS unsigned char* lds = (LAS unsigned char*)lds_raw;
    const int tid = threadIdx.x, lane = tid & 63, wid = __builtin_amdgcn_readfirstlane(tid >> 6);
    const int G = gridDim.x;
    const int gw = blockIdx.x * 8 + wid, NGW = G * 8;
    unsigned char* ws = a.ws;
    float* mod = (float*)(ws + WS_MOD);
    float* modx = (float*)(ws + WS_MODX);
    float* rowss = (float*)(ws + (a.pad ? 190 * MiB : WS_ROWSS));
    bf16_t* WIN = (bf16_t*)(ws + WS_WIN); bf16_t* WOUT = (bf16_t*)(ws + WS_WOUT); bf16_t* SW = (bf16_t*)(ws + WS_SW);
    bf16_t* H = (bf16_t*)a.out;
    bf16_t* CC = (bf16_t*)(ws + WS_CC); bf16_t* Z = (bf16_t*)(ws + WS_Z);
    const int lo = a.ph_lo, hi = a.ph_hi;
#define IN(k) (lo <= (k) && (k) < hi)
    volatile LAS unsigned* xb_st = (volatile LAS unsigned*)(lds + LDS_XB);
    if (tid < 4) xb_st[tid] = 0u;
    __syncthreads();
    XcdBarrier xbar; xbar.bar = (unsigned*)(ws + WS_BAR); xbar.x = 0; xbar.st = xb_st;
    if (a.coop) xbar = xcd_barrier_post((unsigned*)(ws + WS_BAR), xb_st);
#define SEAM(k) do { if (a.coop && IN(k) && IN((k) + 1)) { if (a.coop == 2) cg::this_grid().sync(); else { xcd_barrier(xbar); if (PROBE_REP & 64) xcd_barrier(xbar); } } } while (0)

    if (IN(0)) for (int rep = 0; rep < 1 + (PROBE_REP & 1); ++rep) {
        float* modp = (rep || a.pad) ? (float*)(ws + 190 * MiB) : mod;
        unsigned* gdone = (unsigned*)(ws + WS_Q) + 16 * ((int)blockIdx.x & 7);
        { constexpr int I_GEMV = 64 * 16; const int c = (int)blockIdx.x;
          if (G == 256) { const int n3 = 160; const int base = c < n3 ? 3 * c : 3 * n3 + 6 * (c - n3), cnt = c < n3 ? 3 : 6;
              if (wid < cnt && base + wid < I_GEMV) { const int it = base + wid; const int sh = (it >> 4) & 3;
                  p0_gemv_item(a, sh ? modx + (sh - 1) * 16384 : modp, (it >> 4) * 24 + (it & 15), lane, gdone, sh ? 4096 : 6144); } }
          else for (int it = wid * G + c; it < I_GEMV; it += 8 * G) { const int sh = (it >> 4) & 3; p0_gemv_item(a, sh ? modx + (sh - 1) * 16384 : modp, (it >> 4) * 24 + (it & 15), lane, gdone, sh ? 4096 : 6144); } }
        { for (int e4 = gw * 64 + lane; e4 < 8 * 128 * 128 / 4; e4 += NGW * 64) { const int e = e4 * 4; const int sidx = e & 127, t = (e >> 7) & 127;
              const f32x4 w = *(const f32x4*)(a.sgu_w + e);
              u32x2 o; o.x = cvt_pk_bf16(sidx + 0 <= t ? w[0] : 0.f, sidx + 1 <= t ? w[1] : 0.f); o.y = cvt_pk_bf16(sidx + 2 <= t ? w[2] : 0.f, sidx + 3 <= t ? w[3] : 0.f);
              *(u32x2*)(SW + e) = o; } }
        constexpr int I_WIN = (DM / 128) * (DIN / 128);
        LAS float* scr = (LAS float*)lds;
        for (int it = blockIdx.x; it < I_WIN; it += G) p0_transpose_wg<true>(a.w_in, DM, DIN, WIN, scr, it, tid);
    }
    if (a.coop && IN(0) && IN(1)) {
        if (tid == 0) { unsigned* gd = (unsigned*)(ws + WS_Q); unsigned sp = 0;
            for (;;) { unsigned tot = 0;
#pragma unroll
                for (int j = 0; j < 8; ++j) tot += __hip_atomic_load(gd + 16 * j, __ATOMIC_RELAXED, __HIP_MEMORY_SCOPE_AGENT);
                if (tot >= 64u * 16u) break; __builtin_amdgcn_s_sleep(1); if (++sp > (1u << 22)) break; }
            __builtin_amdgcn_fence(__ATOMIC_ACQUIRE, "agent"); asm volatile("s_waitcnt vmcnt(0)" ::: "memory"); }
        __syncthreads();
    }

    if (IN(1)) for (int rep = 0; rep < 1 + ((PROBE_REP >> 1) & 1); ++rep) {
        for (int m0 = gw; m0 < MTOK; m0 += 2 * NGW) {
            const int m1 = (m0 + NGW < MTOK) ? m0 + NGW : m0;
            const f32x4* xr0 = (const f32x4*)(a.x + (size_t)m0 * DM) + lane; const f32x4* xr1 = (const f32x4*)(a.x + (size_t)m1 * DM) + lane;
            f32x4 v0[8], v1[8]; float ss0 = 0.f, ss1 = 0.f;
#pragma unroll
            for (int j = 0; j < 8; ++j) { v0[j] = xr0[64 * j]; v1[j] = xr1[64 * j]; }
#pragma unroll
            for (int j = 0; j < 8; ++j) { ss0 += (v0[j][0] * v0[j][0] + v0[j][1] * v0[j][1]) + (v0[j][2] * v0[j][2] + v0[j][3] * v0[j][3]); ss1 += (v1[j][0] * v1[j][0] + v1[j][1] * v1[j][1]) + (v1[j][2] * v1[j][2] + v1[j][3] * v1[j][3]); }
            const float rstd0 = 1.0f / sqrtf(wave_sum(ss0) * (1.0f / DM) + EPS), rstd1 = 1.0f / sqrtf(wave_sum(ss1) * (1.0f / DM) + EPS);
            const float* shp0 = mod + (m0 >> 11) * 6144; const float* shp1 = mod + (m1 >> 11) * 6144;
            const float* sx0 = modx + (m0 >> 11) * 4096; const float* sx1 = modx + (m1 >> 11) * 4096;
            u32x2* o0 = (u32x2*)(H + (size_t)m0 * DM) + lane; u32x2* o1 = (u32x2*)(H + (size_t)m1 * DM) + lane;
#pragma unroll
            for (int j = 0; j < 8; ++j) {
                const int k = 4 * (lane + 64 * j);
                const f32x4 gg = *(const f32x4*)(a.norm_g + k);
                const f32x4 sc0 = (*(const f32x4*)(shp0 + 2048 + k) + *(const f32x4*)(sx0 + 2048 + k)) + (*(const f32x4*)(sx0 + 16384 + 2048 + k) + *(const f32x4*)(sx0 + 32768 + 2048 + k));
                const f32x4 sf0 = (*(const f32x4*)(shp0 + k) + *(const f32x4*)(sx0 + k)) + (*(const f32x4*)(sx0 + 16384 + k) + *(const f32x4*)(sx0 + 32768 + k));
                const f32x4 y0 = v0[j] * rstd0 * gg * (sc0 + 1.0f) + sf0;
                const f32x4 sc1 = (*(const f32x4*)(shp1 + 2048 + k) + *(const f32x4*)(sx1 + 2048 + k)) + (*(const f32x4*)(sx1 + 16384 + 2048 + k) + *(const f32x4*)(sx1 + 32768 + 2048 + k));
                const f32x4 sf1 = (*(const f32x4*)(shp1 + k) + *(const f32x4*)(sx1 + k)) + (*(const f32x4*)(sx1 + 16384 + k) + *(const f32x4*)(sx1 + 32768 + k));
                const f32x4 y1 = v1[j] * rstd1 * gg * (sc1 + 1.0f) + sf1;
                u32x2 p0; p0.x = cvt_pk_bf16(y0[0], y0[1]); p0.y = cvt_pk_bf16(y0[2], y0[3]); o0[64 * j] = p0;
                u32x2 p1; p1.x = cvt_pk_bf16(y1[0], y1[1]); p1.y = cvt_pk_bf16(y1[2], y1[3]); o1[64 * j] = p1;
            }
        }
    }
    SEAM(1);

    if (IN(2)) {
        pg8::Gemm g{H, WIN, MTOK, DIN, DM}; pg8::StaticOrder S; S.init(MTOK, DIN, G, (int)blockIdx.x);
        pg8::EpiZ E{Z, (float*)(ws + WS_STATS)};
        pg8::gemm_phase<pg8::EpiZ, pg8::StaticOrder, PG8_ALIGN, PG8_SP2>(lds, g, S, E);
        { constexpr int I_WOUT = (DM / 128) * (DM / 128); const int nwg = (MTOK / 256) * (DIN / 256), rem = nwg % G;
          const int c = (int)blockIdx.x; const bool idle = (rem == 0) || (c >= rem); const int rank = rem == 0 ? c : c - rem, nidle = rem == 0 ? G : G - rem;
          if (idle) {
              for (int it = wid * nidle + rank; it < 64 * 8; it += 8 * nidle) p0_gemv_item(a, mod, (it >> 3) * 24 + 16 + (it & 7), lane);
              for (int it = rank; it < I_WOUT; it += nidle) p0_transpose_wg<false>(a.w_out, DM, DM, WOUT, (LAS float*)lds, it, tid); } }
    }
    SEAM(2);

    if (IN(3)) for (int rep = 0; rep < 1 + ((PROBE_REP >> 3) & 1); ++rep) {
        for (int u = blockIdx.x; u < 512; u += G) {
            if (u < 256) attn_unit(lds, u, Z, CC, a.sinks, tid, wid, lane);
            else sgu_unit(lds, u - 256, Z, CC, SW, (const float*)(ws + WS_STATS), a.ln_g, a.ln_b, a.sgu_b, tid, wid, lane);
        }
    }
    const bool seam3_counted = (G == 256) && a.coop && IN(3) && IN(4);
    unsigned* cnt3 = (unsigned*)(ws + WS_Q + 1024);
    if (seam3_counted) {
        asm volatile("s_waitcnt vmcnt(0)" ::: "memory");
        __syncthreads();
        if (tid == 0) (void)__hip_atomic_fetch_add(cnt3 + 16 * ((int)blockIdx.x >> 3), 1u, __ATOMIC_RELAXED, __HIP_MEMORY_SCOPE_AGENT);
    } else SEAM(3);

    const bool fuse45 = (G == 256) && a.coop;
    if (IN(4)) {
        pg8::Gemm g{CC, WOUT, MTOK, DM, DM}; pg8::StaticOrder S; S.init(MTOK, DM, G, (int)blockIdx.x);
        if (seam3_counted) { pg8::Unit u0; S.next(0, u0);
            if (tid == 0) { unsigned sp = 0;
                while (__hip_atomic_load(cnt3 + 16 * u0.pm, __ATOMIC_RELAXED, __HIP_MEMORY_SCOPE_AGENT) < 8u) { __builtin_amdgcn_s_sleep(1); if (++sp > (1u << 22)) break; }
                __builtin_amdgcn_fence(__ATOMIC_ACQUIRE, "agent"); asm volatile("s_waitcnt vmcnt(0)" ::: "memory"); }
            __syncthreads(); }
        if (fuse45) {
            pg8::EpiOutFused E{a.x, a.out, mod + 4096, a.final_g, rowss, (unsigned*)(ws + WS_CNT)};
            pg8::gemm_phase<pg8::EpiOutFused, pg8::StaticOrder, false, PG8_SP2>(lds, g, S, E);
        } else {
            pg8::EpiOut E{a.x, a.out, mod + 4096, rowss};
            pg8::gemm_phase<pg8::EpiOut, pg8::StaticOrder, PG8_ALIGN, PG8_SP2>(lds, g, S, E);
        }
    }
    if (!fuse45) SEAM(4);

    if (IN(5) && !fuse45) {
        for (int m = gw; m < MTOK; m += NGW) {
            const float rstd = 1.0f / sqrtf(rowss[m] * (1.0f / DM) + EPS);
            f32x4* xr = (f32x4*)(a.out + (size_t)m * DM) + lane;
#pragma unroll
            for (int j = 0; j < 8; ++j) { const f32x4 gg = *(const f32x4*)(a.final_g + 4 * (lane + 64 * j)); xr[64 * j] = xr[64 * j] * rstd * gg; }
        }
    }
#undef IN
#undef SEAM
}

extern "C" void kernel_launch(void* const* d_in, const int* in_sizes, int n_in, void* d_out, int out_size, void* d_ws, size_t ws_size, hipStream_t stream) {
    static int grid = 0;
    if (grid == 0) {
        if (n_in != 13 || out_size != MTOK * DM || ws_size < WS_END) { fprintf(stderr, "kernel_launch: unexpected shapes (n_in %d out %d ws %zu)\n", n_in, out_size, ws_size); grid = -1; return; }
        int dev = 0, cus = 0, per_cu = 0;
        (void)hipGetDevice(&dev);
        (void)hipDeviceGetAttribute(&cus, hipDeviceAttributeMultiprocessorCount, dev);
        if (hipFuncSetAttribute((const void*)fwd_megakernel, hipFuncAttributeMaxDynamicSharedMemorySize, LDS_BYTES) != hipSuccess) { fprintf(stderr, "kernel_launch: hipFuncSetAttribute failed\n"); grid = -1; return; }
        if (hipOccupancyMaxActiveBlocksPerMultiprocessor(&per_cu, (const void*)fwd_megakernel, 512, LDS_BYTES) != hipSuccess || per_cu < 1) { fprintf(stderr, "kernel_launch: occupancy query gave %d\n", per_cu); (void)hipGetLastError(); per_cu = 1; }
        grid = cus * 1;
    }
    if (grid < 0) return;
    (void)hipMemsetAsync((char*)d_ws, 0, CTL_ZERO_BYTES, stream);
    Args a{};
    a.x = (const float*)d_in[0]; a.c = (const float*)d_in[1]; a.norm_g = (const float*)d_in[2]; a.w_ada = (const float*)d_in[3]; a.b_ada = (const float*)d_in[4];
    a.w_in = (const float*)d_in[5]; a.sinks = (const float*)d_in[6]; a.ln_g = (const float*)d_in[7]; a.ln_b = (const float*)d_in[8]; a.sgu_w = (const float*)d_in[9];
    a.sgu_b = (const float*)d_in[10]; a.w_out = (const float*)d_in[11]; a.final_g = (const float*)d_in[12];
    a.out = (float*)d_out; a.ws = (unsigned char*)d_ws; a.pad = 0;
#if MK_N_LAUNCHES == 1
    a.ph_lo = 0; a.ph_hi = 6; a.coop = 1;
    void* args[] = {&a};
    hipError_t e = hipLaunchCooperativeKernel((const void*)fwd_megakernel, dim3(grid), dim3(512), args, LDS_BYTES, stream);
    if (e != hipSuccess) fprintf(stderr, "cooperative launch failed: %s (grid %d)\n", hipGetErrorString(e), grid);
#else
    for (int p = 0; p < 6; ++p) {
        a.ph_lo = p; a.ph_hi = p + 1; a.coop = 0; a.pad = 0;
        hipLaunchKernelGGL(fwd_megakernel, dim3(grid), dim3(512), LDS_BYTES, stream, a);
#ifdef PROBE_DUP
        if (p == PROBE_DUP) { a.pad = 1; hipLaunchKernelGGL(fwd_megakernel, dim3(grid), dim3(512), LDS_BYTES, stream, a); }
#endif
    }
#endif
}
```

```cpp
#include <hip/hip_runtime.h>
#include <hip/hip_cooperative_groups.h>
#include <cstdio>
#include <cstdint>
namespace cg = cooperative_groups;

#ifndef MK_N_LAUNCHES
#define MK_N_LAUNCHES 1
#endif
#ifndef PROBE_REP
#define PROBE_REP 0
#endif

#define LAS __attribute__((address_space(3)))
typedef unsigned short bf16_t;
typedef short bf16x8 __attribute__((ext_vector_type(8)));
typedef float f32x4 __attribute__((ext_vector_type(4)));
typedef float f32x16 __attribute__((ext_vector_type(16)));
typedef unsigned u32x4 __attribute__((ext_vector_type(4)));
typedef unsigned u32x2 __attribute__((ext_vector_type(2)));

constexpr int NB = 4, SEQ = 2048, DM = 2048, MTOK = NB * SEQ, DIN = 5376;
constexpr int DINZ = 4352;
constexpr int C_Q = 0, C_K = 1024, C_V = 1152, C_GA = 1280, C_VS = 2304, C_UG = 3328;
constexpr float EPS = 1e-6f;
constexpr float LOG2E = 1.4426950408889634f;
constexpr float QSCALE = 0.125f * LOG2E;

constexpr size_t MiB = 1u << 20;
constexpr size_t WS_MOD = 4096;
constexpr size_t WS_ROWSS = 128 * 1024;
constexpr size_t WS_CNT = 176 * 1024;
constexpr size_t WS_Q = 184 * 1024;
constexpr size_t WS_BAR = 192 * 1024;
constexpr size_t WS_STATS = 256 * 1024;
constexpr size_t CTL_ZERO_BYTES = 320 * 1024;
constexpr size_t WS_WIN = 2 * MiB;
constexpr size_t WS_WOUT = 24 * MiB;
constexpr size_t WS_SW = 32 * MiB;
constexpr size_t WS_CC = 34 * MiB;
constexpr size_t WS_Z = 66 * MiB;
constexpr size_t WS_END = 150 * MiB;

constexpr int LDS_XB = 141312;
constexpr int LDS_BYTES = LDS_XB + 1024;

__device__ __forceinline__ unsigned cvt_pk_bf16(float lo, float hi) { unsigned r; asm volatile("v_cvt_pk_bf16_f32 %0, %1, %2" : "=v"(r) : "v"(lo), "v"(hi)); return r; }
__device__ __forceinline__ float bf_lo(unsigned u) { return __uint_as_float(u << 16); }
__device__ __forceinline__ float bf_hi(unsigned u) { return __uint_as_float(u & 0xffff0000u); }
__device__ __forceinline__ float wave_sum(float v) {
#pragma unroll
    for (int o = 1; o < 64; o <<= 1) v += __shfl_xor(v, o);
    return v;
}
__device__ __forceinline__ float silu_f(float v) { return v * __builtin_amdgcn_rcpf(1.0f + __builtin_amdgcn_exp2f(-v * LOG2E)); }


#define XB_TMO      128
#define XB_XCNT(j)  (256  + 64 * (j))
#define XB_XSUB(j)  (1280 + 64 * (j))
#define XB_XGEN(j)  (2304 + 64 * (j))
#define XB_TOP      3328
#define XB_TOPGEN   3392
#define XCD_BAR_WORDS 3456
#define XB_SPIN_CAP (1u << 18)
__device__ __forceinline__ unsigned xb_ld(unsigned* p)              { return __hip_atomic_load(p, __ATOMIC_RELAXED, __HIP_MEMORY_SCOPE_AGENT); }
__device__ __forceinline__ unsigned xb_add(unsigned* p, unsigned v) { return __hip_atomic_fetch_add(p, v, __ATOMIC_RELAXED, __HIP_MEMORY_SCOPE_AGENT); }
__device__ __forceinline__ unsigned xb_xcc_id() { return (unsigned)__builtin_amdgcn_s_getreg((3 << 11) | 20) & 0xFu; }
#define XB_SPIN(cond, bar) do { unsigned _sp = 0; while (cond) { __builtin_amdgcn_s_sleep(1); \
    if ((++_sp & 255u) == 0u) { if (xb_ld(&(bar)[XB_TMO])) break; if (_sp > XB_SPIN_CAP) { atomicAdd(&(bar)[XB_TMO], 1u); break; } } } } while (0)
struct XcdBarrier { unsigned* bar; unsigned x; volatile LAS unsigned* st; };
__device__ __forceinline__ XcdBarrier xcd_barrier_post(unsigned* bar, volatile LAS unsigned* st) {
    XcdBarrier b; b.bar = bar; b.x = xb_xcc_id(); b.st = st;
    if (threadIdx.x == 0) (void)xb_add(&bar[XB_XCNT(b.x)], 1u);
    return b;
}
__device__ __forceinline__ void xcd_barrier_complete(unsigned* bar, unsigned x, unsigned& nloc, unsigned& nx) {
    const unsigned G = gridDim.x * gridDim.y * gridDim.z;
    unsigned sum, cnt, mine, sp = 0u;
    for (;;) {
        sum = 0u; cnt = 0u; mine = 0u;
#pragma unroll
        for (unsigned j = 0; j < 16; ++j) { const unsigned c = xb_ld(&bar[XB_XCNT(j)]); sum += c; cnt += (c > 0u) ? 1u : 0u; mine = (j == x) ? c : mine; }
        if (sum == G) break;
        __builtin_amdgcn_s_sleep(1);
        if ((++sp & 255u) == 0u) { if (xb_ld(&bar[XB_TMO])) break; if (sp > XB_SPIN_CAP) { atomicAdd(&bar[XB_TMO], 1u); break; } }
    }
    nloc = mine > 0u ? mine : 1u; nx = cnt > 0u ? cnt : 1u;
}
__device__ __forceinline__ void xcd_barrier(const XcdBarrier& b) {
    asm volatile("s_waitcnt vmcnt(0)" ::: "memory");
    __syncthreads();
    if (threadIdx.x == 0) {
        unsigned* bar = b.bar;
        __builtin_amdgcn_s_waitcnt(0);
        unsigned nloc = b.st[0], nx = b.st[1];
        if (nloc == 0u) { xcd_barrier_complete(bar, b.x, nloc, nx); b.st[0] = nloc; b.st[1] = nx; }
        const unsigned old = xb_add(&bar[XB_XSUB(b.x)], 1u);
        const unsigned gen = old / nloc;
        if (old + 1u == (gen + 1u) * nloc) {
            __builtin_amdgcn_fence(__ATOMIC_RELEASE, "agent");
            asm volatile("s_waitcnt vmcnt(0)" ::: "memory");
            const unsigned og = xb_add(&bar[XB_TOP], 1u);
            const unsigned tg = og / nx;
            if (og + 1u == (tg + 1u) * nx) xb_add(&bar[XB_TOPGEN], 1u);
            else XB_SPIN(xb_ld(&bar[XB_TOPGEN]) == tg, bar);
            __builtin_amdgcn_fence(__ATOMIC_ACQUIRE, "agent");
            xb_add(&bar[XB_XGEN(b.x)], 1u);
            asm volatile("s_waitcnt vmcnt(0)" ::: "memory");
        } else {
            XB_SPIN(xb_ld(&bar[XB_XGEN(b.x)]) == gen, bar);
            __builtin_amdgcn_fence(__ATOMIC_ACQUIRE, "agent");
            asm volatile("s_waitcnt vmcnt(0)" ::: "memory");
        }
    }
    __syncthreads();
}

namespace pg8 {
constexpr int BM = 256, BK = 64, HALF = 128, HTB = HALF * BK * 2, STAGE_BYTES = 8 * HTB, NXCD = 8, WGM = 8;
__host__ __device__ __forceinline__ int lds_byte(int r, int c) { const int st = (r >> 4) * 2 + (c >> 5), rr = r & 15, cc = c & 31, ob = rr * 64 + cc * 2; return st * 1024 + (ob ^ (((ob >> 9) & 1) << 5)); }
__host__ __device__ __forceinline__ void stage_rc(int b, int& R, int& C) { const int st = b / 1024, sb = b % 1024, swz = sb ^ (((sb >> 9) & 1) << 5); R = (st >> 1) * 16 + swz / 64; C = (st & 1) * 32 + (swz % 64) / 2; }
__host__ __device__ __forceinline__ int perm32(int rho) { const int n = rho >> 4, i = rho & 15; return 8 * (i >> 2) + 4 * n + (i & 3); }

struct Unit { int pm, pn; };
struct Gemm { const bf16_t* A; const bf16_t* Bt; int M, N, K; };

struct StaticOrder {
    int nM, nN, nwg, G, c;
    __host__ __device__ void init(int M, int N, int G_, int c_) { nM = M / BM; nN = N / BM; nwg = nM * nN; G = G_; c = c_; }
    __host__ __device__ bool next(int i, Unit& u) const {
        const long L = (long)i * G + c; if (L >= nwg) return false;
        int wgid = (int)L; { const int q = nwg / NXCD, r = nwg % NXCD, xcd = wgid % NXCD, off = wgid / NXCD; wgid = (xcd < r ? xcd * (q + 1) : r * (q + 1) + (xcd - r) * q) + off; }
        const int nig = WGM * nN, gid = wgid / nig, fm = gid * WGM, gsz = (nM - fm) < WGM ? (nM - fm) : WGM;
        u.pm = fm + ((wgid % nig) % gsz); u.pn = (wgid % nig) / gsz; return true;
    }
    __device__ __forceinline__ void a_ready(const Unit&) const {}
    __device__ __forceinline__ void done(const Unit&) const {}
};


struct EpiZ {
    static constexpr bool PERM = true, AFTER_DRAIN = false;
    bf16_t* O; float* stats;
    __device__ __forceinline__ void operator()(const f32x4 (&acc)[2][2][4][2], const Unit& u, int wr, int wc, int fr, int fq) const {
        const int row0 = u.pm * BM + wr * 64 + fr; const int col0 = u.pn * BM + wc * 32 + 8 * fq;
        const int pn = u.pn;
        const int mode = (pn < 4) ? 1 : ((pn >= 5 && pn <= 8) ? 2 : 0);
        if (pn >= 13) {
            const int colz = C_UG + (pn - 13) * 128 + wc * 32 + 8 * fq;
#pragma unroll
            for (int ai = 0; ai < 2; ++ai)
#pragma unroll
                for (int m = 0; m < 4; ++m) { const f32x4 u0 = acc[ai][0][m][0], u1 = acc[ai][0][m][1], g0 = acc[ai][1][m][0], g1 = acc[ai][1][m][1];
                    u32x4 w; w.x = cvt_pk_bf16(u0[0] * silu_f(g0[0]), u0[1] * silu_f(g0[1])); w.y = cvt_pk_bf16(u0[2] * silu_f(g0[2]), u0[3] * silu_f(g0[3]));
                    w.z = cvt_pk_bf16(u1[0] * silu_f(g1[0]), u1[1] * silu_f(g1[1])); w.w = cvt_pk_bf16(u1[2] * silu_f(g1[2]), u1[3] * silu_f(g1[3]));
                    *(u32x4*)(O + (size_t)(row0 + ai * HALF + m * 16) * DINZ + colz) = w; }
            return;
        }
        if (pn >= 9 && pn <= 12) {
#pragma unroll
            for (int ai = 0; ai < 2; ++ai)
#pragma unroll
                for (int m = 0; m < 4; ++m) { float s1 = 0.f, s2 = 0.f;
#pragma unroll
                    for (int bj = 0; bj < 2; ++bj)
#pragma unroll
                        for (int n = 0; n < 2; ++n) { const f32x4 v = acc[ai][bj][m][n]; s1 += (v[0] + v[1]) + (v[2] + v[3]); s2 += (v[0] * v[0] + v[1] * v[1]) + (v[2] * v[2] + v[3] * v[3]); }
                    s1 += __shfl_xor(s1, 16); s1 += __shfl_xor(s1, 32); s2 += __shfl_xor(s2, 16); s2 += __shfl_xor(s2, 32);
                    if (fq == 0) { float* sp = stats + 2 * (size_t)(row0 + ai * HALF + m * 16); atomicAdd(sp, s1); atomicAdd(sp + 1, s2); } }
        }
#pragma unroll
        for (int ai = 0; ai < 2; ++ai)
#pragma unroll
            for (int m = 0; m < 4; ++m) { bf16_t* rowp = O + (size_t)(row0 + ai * HALF + m * 16) * DINZ + col0;
#pragma unroll
                for (int bj = 0; bj < 2; ++bj) { f32x4 v0 = acc[ai][bj][m][0], v1 = acc[ai][bj][m][1];
                    if (mode == 1) { v0 = v0 * QSCALE; v1 = v1 * QSCALE; }
                    else if (mode == 2) {
#pragma unroll
                        for (int j = 0; j < 4; ++j) { v0[j] = silu_f(v0[j]); v1[j] = silu_f(v1[j]); } }
                    u32x4 w; w.x = cvt_pk_bf16(v0[0], v0[1]); w.y = cvt_pk_bf16(v0[2], v0[3]); w.z = cvt_pk_bf16(v1[0], v1[1]); w.w = cvt_pk_bf16(v1[2], v1[3]);
                    *(u32x4*)(rowp + bj * HALF) = w; } }
    }
};

struct EpiOut {
    static constexpr bool PERM = false, AFTER_DRAIN = false;
    const float* x; float* out; const float* gate  ; float* rowss;
    __device__ __forceinline__ void operator()(const f32x4 (&acc)[2][2][4][2], const Unit& u, int wr, int wc, int fr, int fq) const {
        const int row0 = u.pm * BM + wr * 64 + fr; const int col0 = u.pn * BM + wc * 32 + 4 * fq;
        const int b = u.pm >> 3;
        f32x4 gv[2][2];
#pragma unroll
        for (int bj = 0; bj < 2; ++bj)
#pragma unroll
            for (int n = 0; n < 2; ++n) gv[bj][n] = *(const f32x4*)(gate + b * 6144 + col0 + bj * HALF + 16 * n);
#pragma unroll
        for (int ai = 0; ai < 2; ++ai)
#pragma unroll
            for (int m = 0; m < 4; ++m) { const int row = row0 + ai * HALF + m * 16; const size_t ro = (size_t)row * DM + col0; float ss = 0.f;
#pragma unroll
                for (int bj = 0; bj < 2; ++bj)
#pragma unroll
                    for (int n = 0; n < 2; ++n) { const f32x4 xv = *(const f32x4*)(x + ro + bj * HALF + 16 * n); const f32x4 y = xv + gv[bj][n] * acc[ai][bj][m][n];
                        *(f32x4*)(out + ro + bj * HALF + 16 * n) = y; ss += (y[0] * y[0] + y[1] * y[1]) + (y[2] * y[2] + y[3] * y[3]); }
                ss += __shfl_xor(ss, 16); ss += __shfl_xor(ss, 32);
                if (fq == 0) atomicAdd(rowss + row, ss); }
    }
};


struct EpiOutFused {
    static constexpr bool PERM = false, AFTER_DRAIN = true;
    const float* x; float* out; const float* gate; const float* fg; float* rowss; unsigned* cnt;
    __device__ __forceinline__ void fused(f32x4 (&acc)[2][2][4][2], const Unit& u, int wr, int wc, int fr, int fq, LAS unsigned char* lds, int wid, int lane) const {
        LAS float* P = (LAS float*)lds;
        LAS float* S = (LAS float*)(lds + 4096);
        const int rowl0 = wr * 64 + fr; const int col0 = u.pn * BM + wc * 32 + 4 * fq;
        const int b = u.pm >> 3;
        f32x4 gv[2][2];
#pragma unroll
        for (int bj = 0; bj < 2; ++bj)
#pragma unroll
            for (int n = 0; n < 2; ++n) gv[bj][n] = *(const f32x4*)(gate + b * 6144 + col0 + bj * HALF + 16 * n);
#pragma unroll
        for (int ai = 0; ai < 2; ++ai)
#pragma unroll
            for (int m = 0; m < 4; ++m) { const int rowl = rowl0 + ai * HALF + m * 16; const size_t ro = (size_t)(u.pm * BM + rowl) * DM + col0; float ss = 0.f;
#pragma unroll
                for (int bj = 0; bj < 2; ++bj)
#pragma unroll
                    for (int n = 0; n < 2; ++n) { const f32x4 xv = *(const f32x4*)(x + ro + bj * HALF + 16 * n); const f32x4 y = xv + gv[bj][n] * acc[ai][bj][m][n];
                        acc[ai][bj][m][n] = y; ss += (y[0] * y[0] + y[1] * y[1]) + (y[2] * y[2] + y[3] * y[3]); }
                ss += __shfl_xor(ss, 16); ss += __shfl_xor(ss, 32);
                if (fq == 0) P[rowl * 4 + wc] = ss; }
        asm volatile("s_waitcnt lgkmcnt(0)" ::: "memory"); __builtin_amdgcn_s_barrier(); asm volatile("" ::: "memory");
        const int tid = wid * 64 + lane;
        if (tid < 256) { const float t = (P[tid * 4 + 0] + P[tid * 4 + 1]) + (P[tid * 4 + 2] + P[tid * 4 + 3]);
            const float old = __hip_atomic_fetch_add(rowss + u.pm * BM + tid, t, __ATOMIC_RELAXED, __HIP_MEMORY_SCOPE_AGENT); asm volatile("" :: "v"(old)); }
        asm volatile("s_waitcnt vmcnt(0)" ::: "memory"); __builtin_amdgcn_s_barrier(); asm volatile("" ::: "memory");
        if (wid == 0) {
            if (lane == 0) {
                unsigned* c = cnt + 64 * u.pm;
                (void)__hip_atomic_fetch_add(c, 1u, __ATOMIC_RELAXED, __HIP_MEMORY_SCOPE_AGENT);
                unsigned sp = 0;
                while (__hip_atomic_load(c, __ATOMIC_RELAXED, __HIP_MEMORY_SCOPE_AGENT) < 8u) { __builtin_amdgcn_s_sleep(1); if (++sp > (1u << 22)) break; }
            }
            __builtin_amdgcn_fence(__ATOMIC_ACQUIRE, "agent");
        }
        asm volatile("s_waitcnt vmcnt(0) lgkmcnt(0)" ::: "memory"); __builtin_amdgcn_s_barrier(); asm volatile("" ::: "memory");
        if (tid < 256) S[tid] = 1.0f / sqrtf(__hip_atomic_load(rowss + u.pm * BM + tid, __ATOMIC_RELAXED, __HIP_MEMORY_SCOPE_AGENT) * (1.0f / DM) + EPS);
        asm volatile("s_waitcnt vmcnt(0) lgkmcnt(0)" ::: "memory"); __builtin_amdgcn_s_barrier(); asm volatile("" ::: "memory");
        f32x4 fv[2][2];
#pragma unroll
        for (int bj = 0; bj < 2; ++bj)
#pragma unroll
            for (int n = 0; n < 2; ++n) fv[bj][n] = *(const f32x4*)(fg + col0 + bj * HALF + 16 * n);
#pragma unroll
        for (int ai = 0; ai < 2; ++ai)
#pragma unroll
            for (int m = 0; m < 4; ++m) { const int rowl = rowl0 + ai * HALF + m * 16; const size_t ro = (size_t)(u.pm * BM + rowl) * DM + col0; const float rstd = S[rowl];
#pragma unroll
                for (int bj = 0; bj < 2; ++bj)
#pragma unroll
                    for (int n = 0; n < 2; ++n) *(f32x4*)(out + ro + bj * HALF + 16 * n) = acc[ai][bj][m][n] * rstd * fv[bj][n]; }
    }
};

template <class Epi, class Sched, bool ALIGN_EPI = false, bool SP2 = false>
__device__ __forceinline__ void gemm_phase(LAS unsigned char* lds, const Gemm g, const Sched& S, const Epi& E) {
    const int tid = threadIdx.x, wid = __builtin_amdgcn_readfirstlane(tid >> 6), lane = tid & 63, wr = wid >> 2, wc = wid & 3, fr = lane & 15, fq = lane >> 4;
    const int K = g.K, nt = K / BK;
    unsigned voffA[2], voffB[2];
#pragma unroll
    for (int i = 0; i < 2; ++i) { int R, C; stage_rc(tid * 16 + i * 8192, R, C); const int Rb = Epi::PERM ? ((R & ~31) + perm32(R & 31)) : R;
        voffA[i] = (unsigned)(R * K + C) * 2u; voffB[i] = (unsigned)(Rb * K + C) * 2u; }
    const size_t kstep = (size_t)(BK * 2);
    const size_t hstep = (size_t)HALF * K * 2;
    const size_t tstep = 2 * hstep;
    const unsigned ldsw = (unsigned)wid * 1024u;
    const int aoff = lds_byte(wr * 64 + fr, fq * 8), boff = lds_byte(wc * 32 + fr, fq * 8);
#define PG8_SA(b, h) (((b) * 2 + (h)) * HTB)
#define PG8_SB(b, h) ((4 + (b) * 2 + (h)) * HTB)
#define PG8_STAGE(bufoff, gbase, voff) do { _Pragma("unroll") for (int _i = 0; _i < 2; ++_i) \
        __builtin_amdgcn_global_load_lds((const unsigned*)((const char*)(gbase) + (voff)[_i]), (LAS unsigned*)(lds + (bufoff) + ldsw + _i * 8192), 16, 0, 0); } while (0)
#define PG8_LDA(dst, b, h) do { _Pragma("unroll") for (int m = 0; m < 4; ++m) _Pragma("unroll") for (int k = 0; k < 2; ++k) dst[m][k] = *(const LAS bf16x8*)(lds + PG8_SA(b, h) + aoff + m * 2048 + k * 1024); } while (0)
#define PG8_LDB(dst, b, h) do { _Pragma("unroll") for (int n = 0; n < 2; ++n) _Pragma("unroll") for (int k = 0; k < 2; ++k) dst[n][k] = *(const LAS bf16x8*)(lds + PG8_SB(b, h) + boff + n * 2048 + k * 1024); } while (0)
#define PG8_MMA(ai, bj, At, Bt) do { __builtin_amdgcn_s_setprio(1); _Pragma("unroll") for (int m = 0; m < 4; ++m) _Pragma("unroll") for (int n = 0; n < 2; ++n) _Pragma("unroll") for (int k = 0; k < 2; ++k) \
        acc[ai][bj][m][n] = __builtin_amdgcn_mfma_f32_16x16x32_bf16(Bt[n][k], At[m][k], acc[ai][bj][m][n], 0, 0, 0); __builtin_amdgcn_s_setprio(0); } while (0)
#define PG8_WAIT_V(n) asm volatile("s_waitcnt vmcnt(" #n ")" ::: "memory")
#define PG8_WAIT_L(n) asm volatile("s_waitcnt lgkmcnt(" #n ")" ::: "memory")
#define PG8_BAR __builtin_amdgcn_s_barrier()
#define PG8_SCHED __builtin_amdgcn_sched_barrier(0)
    Unit cur, nxt; int ui = 0;
    if (!S.next(0, cur)) return;
    f32x4 acc[2][2][4][2];
#pragma unroll
    for (int a = 0; a < 2; ++a)
#pragma unroll
        for (int b = 0; b < 2; ++b)
#pragma unroll
            for (int m = 0; m < 4; ++m)
#pragma unroll
                for (int n = 0; n < 2; ++n) acc[a][b][m][n] = (f32x4){0.f, 0.f, 0.f, 0.f};
    bf16x8 At[4][2], B0[2][2], B1[2][2];
    const char* cA = (const char*)g.A + (size_t)cur.pm * tstep; const char* cB = (const char*)g.Bt + (size_t)cur.pn * tstep;
    S.a_ready(cur);
    if constexpr (SP2) {
        PG8_STAGE(PG8_SB(0, 0), cB, voffB); PG8_STAGE(PG8_SB(0, 1), cB + hstep, voffB); PG8_STAGE(PG8_SA(0, 0), cA, voffA); PG8_STAGE(PG8_SA(0, 1), cA + hstep, voffA);
        if (wr == 1) PG8_BAR;
        PG8_WAIT_V(2); PG8_BAR;
        PG8_STAGE(PG8_SB(1, 0), cB + kstep, voffB); PG8_STAGE(PG8_SA(1, 0), cA + kstep, voffA); PG8_STAGE(PG8_SB(1, 1), cB + hstep + kstep, voffB);
        PG8_WAIT_V(6); PG8_BAR;
    } else {
        PG8_STAGE(PG8_SB(0, 0), cB, voffB); PG8_STAGE(PG8_SA(0, 0), cA, voffA); PG8_STAGE(PG8_SB(0, 1), cB + hstep, voffB); PG8_STAGE(PG8_SA(0, 1), cA + hstep, voffA);
        if (wr == 1) PG8_BAR;
        PG8_WAIT_V(4); PG8_BAR;
        PG8_STAGE(PG8_SB(1, 0), cB + kstep, voffB); PG8_STAGE(PG8_SA(1, 0), cA + kstep, voffA); PG8_STAGE(PG8_SB(1, 1), cB + hstep + kstep, voffB);
        PG8_WAIT_V(6); PG8_BAR;
    }
    for (;;) {
        const bool has_next = S.next(ui + 1, nxt);
        const char* nA = has_next ? (const char*)g.A + (size_t)nxt.pm * tstep : cA; const char* nB = has_next ? (const char*)g.Bt + (size_t)nxt.pn * tstep : cB;
        for (int t = 0; t < nt; t += 2) {
            const bool last = (t == nt - 2);
            const char* a1 = cA + (size_t)(t + 1) * kstep;
            const char* a2 = last ? nA : cA + (size_t)(t + 2) * kstep; const char* b2 = last ? nB : cB + (size_t)(t + 2) * kstep;
            const char* a3 = a2 + kstep; const char* b3 = b2 + kstep;
            if (last && has_next) S.a_ready(nxt);
            if constexpr (SP2) {
            PG8_LDB(B0, 0, 0); PG8_LDB(B1, 0, 1); PG8_SCHED; PG8_LDA(At, 0, 0); PG8_STAGE(PG8_SA(1, 1), a1 + hstep, voffA);
            PG8_WAIT_V(8); PG8_WAIT_L(0); PG8_BAR; PG8_MMA(0, 0, At, B0); PG8_MMA(0, 1, At, B1); PG8_BAR; PG8_SCHED;
            PG8_LDA(At, 0, 1); PG8_STAGE(PG8_SB(0, 0), b2, voffB); PG8_STAGE(PG8_SB(0, 1), b2 + hstep, voffB); PG8_STAGE(PG8_SA(0, 0), a2, voffA);
            PG8_WAIT_V(8); PG8_WAIT_L(0); PG8_BAR; PG8_MMA(1, 0, At, B0); PG8_MMA(1, 1, At, B1); PG8_BAR; PG8_SCHED;
            PG8_LDB(B0, 1, 0); PG8_LDB(B1, 1, 1); PG8_SCHED; PG8_LDA(At, 1, 0); PG8_STAGE(PG8_SA(0, 1), a2 + hstep, voffA);
            PG8_WAIT_V(8); PG8_WAIT_L(0); PG8_BAR; PG8_MMA(0, 0, At, B0); PG8_MMA(0, 1, At, B1); PG8_BAR; PG8_SCHED;
            PG8_LDA(At, 1, 1); PG8_STAGE(PG8_SB(1, 0), b3, voffB); PG8_STAGE(PG8_SB(1, 1), b3 + hstep, voffB); PG8_STAGE(PG8_SA(1, 0), a3, voffA);
            PG8_WAIT_V(8); PG8_WAIT_L(0); PG8_BAR; PG8_MMA(1, 0, At, B0); PG8_MMA(1, 1, At, B1); PG8_BAR; PG8_SCHED;
            } else {
            PG8_LDB(B0, 0, 0); PG8_SCHED; PG8_LDA(At, 0, 0); PG8_STAGE(PG8_SA(1, 1), a1 + hstep, voffA);
            PG8_WAIT_L(8); PG8_BAR; PG8_WAIT_L(0); PG8_MMA(0, 0, At, B0); PG8_BAR; PG8_SCHED;
            PG8_LDB(B1, 0, 1); PG8_STAGE(PG8_SB(0, 0), b2, voffB);
            PG8_BAR; PG8_WAIT_L(0); PG8_MMA(0, 1, At, B1); PG8_BAR;
            PG8_LDA(At, 0, 1); PG8_STAGE(PG8_SA(0, 0), a2, voffA);
            PG8_BAR; PG8_WAIT_L(0); PG8_MMA(1, 0, At, B0); PG8_BAR; PG8_SCHED;
            PG8_STAGE(PG8_SB(0, 1), b2 + hstep, voffB);
            PG8_WAIT_V(6); PG8_BAR; PG8_MMA(1, 1, At, B1); PG8_BAR;
            PG8_LDB(B0, 1, 0); PG8_SCHED; PG8_LDA(At, 1, 0); PG8_STAGE(PG8_SA(0, 1), a2 + hstep, voffA);
            PG8_WAIT_L(8); PG8_BAR; PG8_WAIT_L(0); PG8_MMA(0, 0, At, B0); PG8_BAR; PG8_SCHED;
            PG8_LDB(B1, 1, 1); PG8_STAGE(PG8_SB(1, 0), b3, voffB);
            PG8_BAR; PG8_WAIT_L(0); PG8_MMA(0, 1, At, B1); PG8_BAR;
            PG8_LDA(At, 1, 1); PG8_STAGE(PG8_SA(1, 0), a3, voffA);
            PG8_BAR; PG8_WAIT_L(0); PG8_MMA(1, 0, At, B0); PG8_BAR; PG8_SCHED;
            PG8_STAGE(PG8_SB(1, 1), b3 + hstep, voffB);
            PG8_WAIT_V(6); PG8_BAR; PG8_MMA(1, 1, At, B1); PG8_BAR;
            }
        }
        if constexpr (ALIGN_EPI) { if (wr == 0) PG8_BAR; }
        if constexpr (!Epi::AFTER_DRAIN) { E(acc, cur, wr, wc, fr, fq); S.done(cur); }
        if (!has_next) break;
#pragma unroll
        for (int a = 0; a < 2; ++a)
#pragma unroll
            for (int b = 0; b < 2; ++b)
#pragma unroll
                for (int m = 0; m < 4; ++m)
#pragma unroll
                    for (int n = 0; n < 2; ++n) acc[a][b][m][n] = (f32x4){0.f, 0.f, 0.f, 0.f};
        cur = nxt; cA = nA; cB = nB; ++ui;
        if constexpr (ALIGN_EPI) { if (wr == 1) PG8_BAR; }
    }
    PG8_WAIT_V(0);
    if constexpr (!ALIGN_EPI) { if (wr == 0) PG8_BAR; }
    PG8_BAR;
    if constexpr (Epi::AFTER_DRAIN) { E.fused(acc, cur, wr, wc, fr, fq, lds, wid, lane); S.done(cur); }
#undef PG8_SA
#undef PG8_SB
#undef PG8_STAGE
#undef PG8_LDA
#undef PG8_LDB
#undef PG8_MMA
#undef PG8_WAIT_V
#undef PG8_WAIT_L
#undef PG8_BAR
#undef PG8_SCHED
}
}

#ifndef PG8_SP2
#define PG8_SP2 true
#endif
#ifndef PG8_ALIGN
#define PG8_ALIGN true
#endif

struct Args {
    const float* x; const float* c; const float* norm_g; const float* w_ada; const float* b_ada; const float* w_in; const float* sinks;
    const float* ln_g; const float* ln_b; const float* sgu_w; const float* sgu_b; const float* w_out; const float* final_g;
    float* out; unsigned char* ws; int ph_lo, ph_hi, coop, pad;
};

template <bool PERM_IN>
__device__ __forceinline__ void p0_transpose_wg(const float* W, int K, int N, bf16_t* WT, LAS float* scr, int item, int tid) {
    const int nblk = N / 128, kb = item / nblk, nb = item % nblk, k0 = 128 * kb, n0 = 128 * nb;
    int nd = n0;
    if (PERM_IN) { const int ob = nb; const int nbk = ob < 18 ? ob : (ob < 26 ? 26 + 2 * (ob - 18) : (ob < 34 ? ob - 8 : 27 + 2 * (ob - 34))); nd = 128 * nbk; }
    f32x4 v[8];
#pragma unroll
    for (int i = 0; i < 8; ++i) { const int idx = tid + 512 * i, k = idx >> 5, c4 = idx & 31; v[i] = *(const f32x4*)(W + (size_t)(k0 + k) * N + n0 + 4 * c4); }
#pragma unroll
    for (int i = 0; i < 8; ++i) { const int idx = tid + 512 * i, k = idx >> 5, c4 = idx & 31; *(LAS f32x4*)(scr + k * 132 + 4 * c4) = v[i]; }
    __syncthreads();
#pragma unroll
    for (int i = 0; i < 4; ++i) { const int q = tid + 512 * i, n = q & 127, c = q >> 7; const LAS float* s = scr + (8 * c) * 132 + n;
        u32x4 o; o.x = cvt_pk_bf16(s[0 * 132], s[1 * 132]); o.y = cvt_pk_bf16(s[2 * 132], s[3 * 132]); o.z = cvt_pk_bf16(s[4 * 132], s[5 * 132]); o.w = cvt_pk_bf16(s[6 * 132], s[7 * 132]);
        *(u32x4*)(WT + (size_t)(nd + n) * K + k0 + 8 * c) = o; }
    __syncthreads();
}
__device__ __forceinline__ void p0_gemv_item(const Args& a, float* mod, int item, int lane, unsigned* done = nullptr) {
    const int kc = item / 24, nc = item % 24; const int k0 = kc * 32, n0 = nc * 256 + lane * 4;
    const int kl = k0 + (lane & 31);
    const int cs0 = __float_as_int(silu_f(a.c[0 * DM + kl])), cs1 = __float_as_int(silu_f(a.c[1 * DM + kl])), cs2 = __float_as_int(silu_f(a.c[2 * DM + kl])), cs3 = __float_as_int(silu_f(a.c[3 * DM + kl]));
    f32x4 acc0 = {0.f, 0.f, 0.f, 0.f}, acc1 = acc0, acc2 = acc0, acc3 = acc0;
    const float* wp = a.w_ada + (size_t)k0 * 6144 + n0;
    f32x4 w[32];
#pragma unroll
    for (int k = 0; k < 32; ++k) w[k] = *(const f32x4*)(wp + (size_t)k * 6144);
    __builtin_amdgcn_sched_barrier(0);
#pragma unroll
    for (int k = 0; k < 32; ++k) {
        const float c0 = __int_as_float(__builtin_amdgcn_readlane(cs0, k)), c1 = __int_as_float(__builtin_amdgcn_readlane(cs1, k)), c2 = __int_as_float(__builtin_amdgcn_readlane(cs2, k)), c3 = __int_as_float(__builtin_amdgcn_readlane(cs3, k));
        acc0 += w[k] * c0; acc1 += w[k] * c1; acc2 += w[k] * c2; acc3 += w[k] * c3;
    }
    if (kc == 0) { const f32x4 bb = *(const f32x4*)(a.b_ada + n0); acc0 += bb; acc1 += bb; acc2 += bb; acc3 += bb; }
#pragma unroll
    for (int j = 0; j < 4; ++j) { atomicAdd(mod + 0 * 6144 + n0 + j, acc0[j]); atomicAdd(mod + 1 * 6144 + n0 + j, acc1[j]); atomicAdd(mod + 2 * 6144 + n0 + j, acc2[j]); atomicAdd(mod + 3 * 6144 + n0 + j, acc3[j]); }
    if (done) {
        float z = 0.f; asm volatile("" : "+v"(z));
        const float r0 = __hip_atomic_fetch_add(mod + 0 * 6144 + n0 + 3, z, __ATOMIC_RELAXED, __HIP_MEMORY_SCOPE_AGENT), r1 = __hip_atomic_fetch_add(mod + 1 * 6144 + n0 + 3, z, __ATOMIC_RELAXED, __HIP_MEMORY_SCOPE_AGENT);
        const float r2 = __hip_atomic_fetch_add(mod + 2 * 6144 + n0 + 3, z, __ATOMIC_RELAXED, __HIP_MEMORY_SCOPE_AGENT), r3 = __hip_atomic_fetch_add(mod + 3 * 6144 + n0 + 3, z, __ATOMIC_RELAXED, __HIP_MEMORY_SCOPE_AGENT);
        asm volatile("" :: "v"(r0), "v"(r1), "v"(r2), "v"(r3));
        asm volatile("s_waitcnt vmcnt(0)" ::: "memory");
        if (lane == 0) (void)__hip_atomic_fetch_add(done, 1u, __ATOMIC_RELAXED, __HIP_MEMORY_SCOPE_AGENT);
    }
}

constexpr int KPITCH = 144, VPITCH = 520, OPITCH = 144;
constexpr int ATT_K = 0, ATT_V = 256 * KPITCH, ATT_O = ATT_V + 64 * VPITCH;
__device__ __forceinline__ void attn_unit(LAS unsigned char* lds, int unit, const bf16_t* Z, bf16_t* CC, const float* sinks, int tid, int wid, int lane) {
    const int hh = unit & 1, kvh = (unit >> 1) & 1, nb = (unit >> 2) & 15, b = unit >> 6;
    const int tok0 = b * SEQ + nb * 128;
    const __amdgpu_buffer_rsrc_t ccr = __builtin_amdgcn_make_buffer_rsrc((void*)CC, 0, MTOK * DM * 2, 0x00020000);
    LAS unsigned char* Kl = lds + ATT_K;
    LAS unsigned char* Vt = lds + ATT_V;
    LAS unsigned char* Ow = lds + ATT_O + wid * (32 * OPITCH);
    const int r = lane & 31, h = lane >> 5;
#pragma unroll
    for (int i = 0; i < 4; ++i) {
        const int ch = tid + 512 * i, key = ch >> 3, c8 = ch & 7;
        const bool valid = (nb > 0) || (key >= 128);
        u32x4 kv = {0u, 0u, 0u, 0u}, vv = {0u, 0u, 0u, 0u};
        if (valid) { const bf16_t* row = Z + (size_t)(tok0 - 128 + key) * DINZ + kvh * 64 + c8 * 8; kv = *(const u32x4*)(row + C_K); vv = *(const u32x4*)(row + C_V); }
        *(LAS u32x4*)(Kl + key * KPITCH + c8 * 16) = kv;
        LAS bf16_t* vt = (LAS bf16_t*)(Vt + (c8 * 8) * VPITCH + key * 2);
        vt[0 * (VPITCH / 2)] = (bf16_t)(vv.x & 0xffffu); vt[1 * (VPITCH / 2)] = (bf16_t)(vv.x >> 16);
        vt[2 * (VPITCH / 2)] = (bf16_t)(vv.y & 0xffffu); vt[3 * (VPITCH / 2)] = (bf16_t)(vv.y >> 16);
        vt[4 * (VPITCH / 2)] = (bf16_t)(vv.z & 0xffffu); vt[5 * (VPITCH / 2)] = (bf16_t)(vv.z >> 16);
        vt[6 * (VPITCH / 2)] = (bf16_t)(vv.w & 0xffffu); vt[7 * (VPITCH / 2)] = (bf16_t)(vv.w >> 16);
    }
    __syncthreads();
#pragma unroll 1
    for (int pi = 0; pi < 2; ++pi) {
        const int p = wid * 2 + pi, hl = p >> 2, qb = p & 3;
        const int head = kvh * 8 + hh * 4 + hl;
        bf16x8 qf[4]; u32x4 gt[4];
        { const bf16_t* qrow = Z + (size_t)(tok0 + qb * 32 + r) * DINZ + C_Q + head * 64 + 8 * h;
#pragma unroll
          for (int ks = 0; ks < 4; ++ks) qf[ks] = *(const bf16x8*)(qrow + 16 * ks);
#pragma unroll
          for (int j = 0; j < 4; ++j) { const int idx = lane + 64 * j, row = idx >> 3, ch = idx & 7;
              gt[j] = *(const u32x4*)(Z + (size_t)(tok0 + qb * 32 + row) * DINZ + C_GA + head * 64 + ch * 8); } }
        f32x16 S[5];
#pragma unroll
        for (int kbi = 0; kbi < 5; ++kbi) {
            const float binit = 0.f; const bool bvalid = ((nb > 0) || (qb + kbi >= 4));
#pragma unroll
            for (int i = 0; i < 16; ++i) S[kbi][i] = binit;
            const LAS unsigned char* kp = Kl + (32 * (qb + kbi) + r) * KPITCH + 16 * h;
#pragma unroll
            for (int ks = 0; ks < 4; ++ks) { const bf16x8 kf = *(const LAS bf16x8*)(kp + 32 * ks); S[kbi] = __builtin_amdgcn_mfma_f32_32x32x16_bf16(kf, qf[ks], S[kbi], 0, 0, 0); }
            if (!bvalid) {
#pragma unroll
                for (int i = 0; i < 16; ++i) S[kbi][i] = -1.0e30f; }
        }
        const float sink_l2 = sinks[head] * LOG2E;
        float mx = sink_l2;
        int tq = r - 4 * h; asm volatile("" : "+v"(tq));
#pragma unroll
        for (int i = 0; i < 16; ++i) { const int cst = (i & 3) + 8 * (i >> 2);
            S[0][i] = (tq >= cst) ? -1.0e30f : S[0][i]; S[4][i] = (tq < cst) ? -1.0e30f : S[4][i]; }
#pragma unroll
        for (int kbi = 0; kbi < 5; ++kbi)
#pragma unroll
            for (int i = 0; i < 16; ++i) mx = fmaxf(mx, S[kbi][i]);
        mx = fmaxf(mx, __shfl_xor(mx, 32));
        typedef float f32x2 __attribute__((ext_vector_type(2)));
        f32x2 lv = {0.f, 0.f}; const f32x2 mxv = {mx, mx};
#pragma unroll
        for (int kbi = 0; kbi < 5; ++kbi)
#pragma unroll
            for (int i = 0; i < 16; i += 2) { const f32x2 d = (f32x2){S[kbi][i], S[kbi][i + 1]} - mxv;
                f32x2 pv; pv.x = __builtin_amdgcn_exp2f(d.x); pv.y = __builtin_amdgcn_exp2f(d.y); S[kbi][i] = pv.x; S[kbi][i + 1] = pv.y; lv += pv; }
        float l = lv.x + lv.y;
        l += __shfl_xor(l, 32);
        l += __builtin_amdgcn_exp2f(sink_l2 - mx);
        f32x16 O[2];
#pragma unroll
        for (int db = 0; db < 2; ++db)
#pragma unroll
            for (int i = 0; i < 16; ++i) O[db][i] = 0.f;
#pragma unroll
        for (int kbi = 0; kbi < 5; ++kbi)
#pragma unroll
            for (int sh = 0; sh < 2; ++sh) {
                u32x4 pw; pw.x = cvt_pk_bf16(S[kbi][8 * sh + 0], S[kbi][8 * sh + 1]); pw.y = cvt_pk_bf16(S[kbi][8 * sh + 2], S[kbi][8 * sh + 3]);
                pw.z = cvt_pk_bf16(S[kbi][8 * sh + 4], S[kbi][8 * sh + 5]); pw.w = cvt_pk_bf16(S[kbi][8 * sh + 6], S[kbi][8 * sh + 7]);
                const bf16x8 pf = __builtin_bit_cast(bf16x8, pw);
#pragma unroll
                for (int db = 0; db < 2; ++db) {
                    const LAS unsigned char* vp = Vt + (32 * db + r) * VPITCH + (32 * (qb + kbi) + 16 * sh + 4 * h) * 2;
                    const u32x2 lo = *(const LAS u32x2*)vp, hi = *(const LAS u32x2*)(vp + 16);
                    u32x4 vw; vw.x = lo.x; vw.y = lo.y; vw.z = hi.x; vw.w = hi.y;
                    O[db] = __builtin_amdgcn_mfma_f32_32x32x16_bf16(__builtin_bit_cast(bf16x8, vw), pf, O[db], 0, 0, 0);
                }
            }
        const float inv = 1.0f / l;
#pragma unroll
        for (int db = 0; db < 2; ++db)
#pragma unroll
            for (int q4 = 0; q4 < 4; ++q4) {
                u32x2 ow; ow.x = cvt_pk_bf16(O[db][4 * q4 + 0] * inv, O[db][4 * q4 + 1] * inv); ow.y = cvt_pk_bf16(O[db][4 * q4 + 2] * inv, O[db][4 * q4 + 3] * inv);
                *(LAS u32x2*)(Ow + r * OPITCH + (32 * db + 8 * q4 + 4 * h) * 2) = ow;
            }
        asm volatile("s_waitcnt lgkmcnt(0)" ::: "memory");
#pragma unroll
        for (int j = 0; j < 4; ++j) { const int idx = lane + 64 * j, row = idx >> 3, ch = idx & 7;
            const u32x4 ov = *(const LAS u32x4*)(Ow + row * OPITCH + ch * 16); const u32x4 gg = gt[j];
            u32x4 w;
            w.x = cvt_pk_bf16(bf_lo(ov.x) * bf_lo(gg.x), bf_hi(ov.x) * bf_hi(gg.x)); w.y = cvt_pk_bf16(bf_lo(ov.y) * bf_lo(gg.y), bf_hi(ov.y) * bf_hi(gg.y));
            w.z = cvt_pk_bf16(bf_lo(ov.z) * bf_lo(gg.z), bf_hi(ov.z) * bf_hi(gg.z)); w.w = cvt_pk_bf16(bf_lo(ov.w) * bf_lo(gg.w), bf_hi(ov.w) * bf_hi(gg.w));
            __builtin_amdgcn_raw_buffer_store_b128(w, ccr, (unsigned)(((tok0 + qb * 32 + row) * DM + head * 64 + ch * 8) * 2), 0, 16); }
        asm volatile("s_waitcnt lgkmcnt(0)" ::: "memory");
    }
    __syncthreads();
}

constexpr int NPITCH = 272, MPITCH = 528;
constexpr int SGU_VN = 0, SGU_MT = 2 * 128 * NPITCH;
__device__ __forceinline__ void sgu_unit(LAS unsigned char* lds, int unit, const bf16_t* Z, bf16_t* CC, const bf16_t* SW, const float* stats, const float* ln_g, const float* ln_b, const float* sgu_b, int tid, int wid, int lane) {
    const int gp = unit & 3, chunk = (unit >> 2) & 15, b = unit >> 6;
    const int tok0 = b * SEQ + chunk * 128;
    const __amdgpu_buffer_rsrc_t ccr = __builtin_amdgcn_make_buffer_rsrc((void*)CC, 0, MTOK * DM * 2, 0x00020000);
    LAS unsigned char* VN = lds + SGU_VN;
    LAS unsigned char* Mt = lds + SGU_MT;
    {
        u32x4 vv[8]; float mean[4], rstd[4];
#pragma unroll
        for (int i = 0; i < 8; ++i) { const int ch = tid + 512 * i, g2 = ch >> 11, s = (ch >> 4) & 127, c8 = ch & 15;
            vv[i] = *(const u32x4*)(Z + (size_t)(tok0 + s) * DINZ + C_VS + (2 * gp + g2) * 128 + c8 * 8); }
#pragma unroll
        for (int i = 0; i < 4; ++i) { const int s = ((tid + 512 * i) >> 4) & 127; const float s1 = stats[2 * (tok0 + s)], s2 = stats[2 * (tok0 + s) + 1];
            mean[i] = s1 * (1.0f / 1024.0f); rstd[i] = 1.0f / sqrtf(fmaxf(s2 * (1.0f / 1024.0f) - mean[i] * mean[i], 0.f) + EPS); }
#pragma unroll
        for (int i = 0; i < 8; ++i) {
            const int ch = tid + 512 * i, g2 = ch >> 11, s = (ch >> 4) & 127, c8 = ch & 15, g = 2 * gp + g2;
            const float mu = mean[i & 3], rs = rstd[i & 3];
            const f32x4 g0 = *(const f32x4*)(ln_g + g * 128 + c8 * 8), g1 = *(const f32x4*)(ln_g + g * 128 + c8 * 8 + 4);
            const f32x4 b0 = *(const f32x4*)(ln_b + g * 128 + c8 * 8), b1 = *(const f32x4*)(ln_b + g * 128 + c8 * 8 + 4);
            LAS bf16_t* vt = (LAS bf16_t*)(VN + g2 * 128 * NPITCH + (c8 * 8) * NPITCH + ((((s >> 3) ^ c8) & 15) << 4) + (s & 7) * 2);
            const u32x4 v = vv[i];
            const float y0 = (bf_lo(v.x) - mu) * rs * g0[0] + b0[0], y1 = (bf_hi(v.x) - mu) * rs * g0[1] + b0[1];
            const float y2 = (bf_lo(v.y) - mu) * rs * g0[2] + b0[2], y3 = (bf_hi(v.y) - mu) * rs * g0[3] + b0[3];
            const float y4 = (bf_lo(v.z) - mu) * rs * g1[0] + b1[0], y5 = (bf_hi(v.z) - mu) * rs * g1[1] + b1[1];
            const float y6 = (bf_lo(v.w) - mu) * rs * g1[2] + b1[2], y7 = (bf_hi(v.w) - mu) * rs * g1[3] + b1[3];
            const unsigned p0 = cvt_pk_bf16(y0, y1), p1 = cvt_pk_bf16(y2, y3), p2 = cvt_pk_bf16(y4, y5), p3 = cvt_pk_bf16(y6, y7);
            vt[0 * (NPITCH / 2)] = (bf16_t)(p0 & 0xffffu); vt[1 * (NPITCH / 2)] = (bf16_t)(p0 >> 16);
            vt[2 * (NPITCH / 2)] = (bf16_t)(p1 & 0xffffu); vt[3 * (NPITCH / 2)] = (bf16_t)(p1 >> 16);
            vt[4 * (NPITCH / 2)] = (bf16_t)(p2 & 0xffffu); vt[5 * (NPITCH / 2)] = (bf16_t)(p2 >> 16);
            vt[6 * (NPITCH / 2)] = (bf16_t)(p3 & 0xffffu); vt[7 * (NPITCH / 2)] = (bf16_t)(p3 >> 16);
        }
    }
    u32x4 ug[8];
#pragma unroll
    for (int i = 0; i < 8; ++i) { const int q = tid + 512 * i, t = q >> 5, c8 = q & 31; ug[i] = *(const u32x4*)(Z + (size_t)(tok0 + t) * DINZ + C_UG + gp * 256 + c8 * 8); }
    __syncthreads();
    {
        const int r = lane & 31, h = lane >> 5;
        const int g2 = wid >> 2, cb = wid & 3, g = 2 * gp + g2;
        bf16x8 af[8];
        { const LAS unsigned char* ap = VN + g2 * 128 * NPITCH + (32 * cb + r) * NPITCH; const int c8r = (4 * cb + (r >> 3)) & 15;
#pragma unroll
          for (int ks = 0; ks < 8; ++ks) af[ks] = *(const LAS bf16x8*)(ap + ((((2 * ks + h) ^ c8r) & 15) << 4)); }
#pragma unroll
        for (int tb = 0; tb < 4; ++tb) {
            f32x16 acc;
#pragma unroll
            for (int i = 0; i < 16; ++i) acc[i] = 0.f;
            const int t = 32 * tb + r;
            const bf16_t* wrow = SW + (size_t)(g * 128 + t) * 128 + 8 * h;
#pragma unroll
            for (int ks = 0; ks < 2 * tb + 2; ++ks) { const bf16x8 wf = *(const bf16x8*)(wrow + 16 * ks); acc = __builtin_amdgcn_mfma_f32_32x32x16_bf16(af[ks], wf, acc, 0, 0, 0); }
            const float bias = sgu_b[g * 128 + t];
#pragma unroll
            for (int q4 = 0; q4 < 4; ++q4) {
                u32x2 ow; ow.x = cvt_pk_bf16(acc[4 * q4 + 0] + bias, acc[4 * q4 + 1] + bias); ow.y = cvt_pk_bf16(acc[4 * q4 + 2] + bias, acc[4 * q4 + 3] + bias);
                *(LAS u32x2*)(Mt + t * MPITCH + (g2 * 128 + 32 * cb + 8 * q4 + 4 * h) * 2) = ow;
            }
        }
    }
    __syncthreads();
#pragma unroll
    for (int i = 0; i < 8; ++i) { const int q = tid + 512 * i, t = q >> 5, c8 = q & 31;
        const u32x4 mv = *(const LAS u32x4*)(Mt + t * MPITCH + c8 * 16); const u32x4 u4 = ug[i];
        u32x4 w;
        w.x = cvt_pk_bf16(bf_lo(u4.x) * bf_lo(mv.x), bf_hi(u4.x) * bf_hi(mv.x));
        w.y = cvt_pk_bf16(bf_lo(u4.y) * bf_lo(mv.y), bf_hi(u4.y) * bf_hi(mv.y));
        w.z = cvt_pk_bf16(bf_lo(u4.z) * bf_lo(mv.z), bf_hi(u4.z) * bf_hi(mv.z));
        w.w = cvt_pk_bf16(bf_lo(u4.w) * bf_lo(mv.w), bf_hi(u4.w) * bf_hi(mv.w));
        __builtin_amdgcn_raw_buffer_store_b128(w, ccr, (unsigned)(((tok0 + t) * DM + 1024 + gp * 256 + c8 * 8) * 2), 0, 16); }
    __syncthreads();
}

__global__ void __launch_bounds__(512, 2) fwd_megakernel(Args a) {
    extern __shared__ __attribute__((aligned(16))) unsigned char lds_raw[];
    LAS unsigned char* lds = (LAS unsigned char*)lds_raw;
    const int tid = threadIdx.x, lane = tid & 63, wid = __builtin_amdgcn_readfirstlane(tid >> 6);
    const int G = gridDim.x;
    const int gw = blockIdx.x * 8 + wid, NGW = G * 8;
    unsigned char* ws = a.ws;
    float* mod = (float*)(ws + WS_MOD);
    float* rowss = (float*)(ws + (a.pad ? 190 * MiB : WS_ROWSS));
    bf16_t* WIN = (bf16_t*)(ws + WS_WIN); bf16_t* WOUT = (bf16_t*)(ws + WS_WOUT); bf16_t* SW = (bf16_t*)(ws + WS_SW);
    bf16_t* H = (bf16_t*)a.out;
    bf16_t* CC = (bf16_t*)(ws + WS_CC); bf16_t* Z = (bf16_t*)(ws + WS_Z);
    const int lo = a.ph_lo, hi = a.ph_hi;
#define IN(k) (lo <= (k) && (k) < hi)
    volatile LAS unsigned* xb_st = (volatile LAS unsigned*)(lds + LDS_XB);
    if (tid < 4) xb_st[tid] = 0u;
    __syncthreads();
    XcdBarrier xbar; xbar.bar = (unsigned*)(ws + WS_BAR); xbar.x = 0; xbar.st = xb_st;
    if (a.coop) xbar = xcd_barrier_post((unsigned*)(ws + WS_BAR), xb_st);
#define SEAM(k) do { if (a.coop && IN(k) && IN((k) + 1)) { if (a.coop == 2) cg::this_grid().sync(); else { xcd_barrier(xbar); if (PROBE_REP & 64) xcd_barrier(xbar); } } } while (0)

    if (IN(0)) for (int rep = 0; rep < 1 + (PROBE_REP & 1); ++rep) {
        float* modp = (rep || a.pad) ? (float*)(ws + 190 * MiB) : mod;
        unsigned* gdone = (unsigned*)(ws + WS_Q) + 16 * ((int)blockIdx.x & 15);
        { constexpr int I_GEMV = 64 * 16; const int c = (int)blockIdx.x;
          if (G == 256) { const int n3 = 160; const int base = c < n3 ? 3 * c : 3 * n3 + 6 * (c - n3), cnt = c < n3 ? 3 : 6;
              if (wid < cnt && base + wid < I_GEMV) { const int it = base + wid; p0_gemv_item(a, modp, (it >> 4) * 24 + (it & 15), lane, gdone); } }
          else for (int it = wid * G + c; it < I_GEMV; it += 8 * G) p0_gemv_item(a, modp, (it >> 4) * 24 + (it & 15), lane, gdone); }
        { for (int e4 = gw * 64 + lane; e4 < 8 * 128 * 128 / 4; e4 += NGW * 64) { const int e = e4 * 4; const int sidx = e & 127, t = (e >> 7) & 127;
              const f32x4 w = *(const f32x4*)(a.sgu_w + e);
              u32x2 o; o.x = cvt_pk_bf16(sidx + 0 <= t ? w[0] : 0.f, sidx + 1 <= t ? w[1] : 0.f); o.y = cvt_pk_bf16(sidx + 2 <= t ? w[2] : 0.f, sidx + 3 <= t ? w[3] : 0.f);
              *(u32x2*)(SW + e) = o; } }
        constexpr int I_WIN = (DM / 128) * (DIN / 128);
        LAS float* scr = (LAS float*)lds;
        for (int it = blockIdx.x; it < I_WIN; it += G) p0_transpose_wg<true>(a.w_in, DM, DIN, WIN, scr, it, tid);
    }
    if (a.coop && IN(0) && IN(1)) {
        if (tid == 0) { unsigned* gd = (unsigned*)(ws + WS_Q); unsigned sp = 0;
            for (;;) { unsigned tot = 0;
#pragma unroll
                for (int j = 0; j < 16; ++j) tot += __hip_atomic_load(gd + 16 * j, __ATOMIC_RELAXED, __HIP_MEMORY_SCOPE_AGENT);
                if (tot >= 64u * 16u) break; __builtin_amdgcn_s_sleep(1); if (++sp > (1u << 22)) break; }
            __builtin_amdgcn_fence(__ATOMIC_ACQUIRE, "agent"); asm volatile("s_waitcnt vmcnt(0)" ::: "memory"); }
        __syncthreads();
    }

    if (IN(1)) for (int rep = 0; rep < 1 + ((PROBE_REP >> 1) & 1); ++rep) {
        for (int m0 = gw; m0 < MTOK; m0 += 2 * NGW) {
            const int m1 = (m0 + NGW < MTOK) ? m0 + NGW : m0;
            const f32x4* xr0 = (const f32x4*)(a.x + (size_t)m0 * DM) + lane; const f32x4* xr1 = (const f32x4*)(a.x + (size_t)m1 * DM) + lane;
            f32x4 v0[8], v1[8]; float ss0 = 0.f, ss1 = 0.f;
#pragma unroll
            for (int j = 0; j < 8; ++j) { v0[j] = xr0[64 * j]; v1[j] = xr1[64 * j]; }
#pragma unroll
            for (int j = 0; j < 8; ++j) { ss0 += (v0[j][0] * v0[j][0] + v0[j][1] * v0[j][1]) + (v0[j][2] * v0[j][2] + v0[j][3] * v0[j][3]); ss1 += (v1[j][0] * v1[j][0] + v1[j][1] * v1[j][1]) + (v1[j][2] * v1[j][2] + v1[j][3] * v1[j][3]); }
            const float rstd0 = 1.0f / sqrtf(wave_sum(ss0) * (1.0f / DM) + EPS), rstd1 = 1.0f / sqrtf(wave_sum(ss1) * (1.0f / DM) + EPS);
            const float* shp0 = mod + (m0 >> 11) * 6144; const float* shp1 = mod + (m1 >> 11) * 6144;
            u32x2* o0 = (u32x2*)(H + (size_t)m0 * DM) + lane; u32x2* o1 = (u32x2*)(H + (size_t)m1 * DM) + lane;
#pragma unroll
            for (int j = 0; j < 8; ++j) {
                const int k = 4 * (lane + 64 * j);
                const f32x4 gg = *(const f32x4*)(a.norm_g + k);
                const f32x4 y0 = v0[j] * rstd0 * gg * (*(const f32x4*)(shp0 + 2048 + k) + 1.0f) + *(const f32x4*)(shp0 + k);
                const f32x4 y1 = v1[j] * rstd1 * gg * (*(const f32x4*)(shp1 + 2048 + k) + 1.0f) + *(const f32x4*)(shp1 + k);
                u32x2 p0; p0.x = cvt_pk_bf16(y0[0], y0[1]); p0.y = cvt_pk_bf16(y0[2], y0[3]); o0[64 * j] = p0;
                u32x2 p1; p1.x = cvt_pk_bf16(y1[0], y1[1]); p1.y = cvt_pk_bf16(y1[2], y1[3]); o1[64 * j] = p1;
            }
        }
    }
    SEAM(1);

    if (IN(2)) {
        pg8::Gemm g{H, WIN, MTOK, DIN, DM}; pg8::StaticOrder S; S.init(MTOK, DIN, G, (int)blockIdx.x);
        pg8::EpiZ E{Z, (float*)(ws + WS_STATS)};
        pg8::gemm_phase<pg8::EpiZ, pg8::StaticOrder, PG8_ALIGN, PG8_SP2>(lds, g, S, E);
        { constexpr int I_WOUT = (DM / 128) * (DM / 128); const int nwg = (MTOK / 256) * (DIN / 256), rem = nwg % G;
          const int c = (int)blockIdx.x; const bool idle = (rem == 0) || (c >= rem); const int rank = rem == 0 ? c : c - rem, nidle = rem == 0 ? G : G - rem;
          if (idle) {
              for (int it = wid * nidle + rank; it < 64 * 8; it += 8 * nidle) p0_gemv_item(a, mod, (it >> 3) * 24 + 16 + (it & 7), lane);
              for (int it = rank; it < I_WOUT; it += nidle) p0_transpose_wg<false>(a.w_out, DM, DM, WOUT, (LAS float*)lds, it, tid); } }
    }
    SEAM(2);

    if (IN(3)) for (int rep = 0; rep < 1 + ((PROBE_REP >> 3) & 1); ++rep) {
        for (int u = blockIdx.x; u < 512; u += G) {
            if (u < 256) attn_unit(lds, u, Z, CC, a.sinks, tid, wid, lane);
            else sgu_unit(lds, u - 256, Z, CC, SW, (const float*)(ws + WS_STATS), a.ln_g, a.ln_b, a.sgu_b, tid, wid, lane);
        }
    }
    const bool seam3_counted = (G == 256) && a.coop && IN(3) && IN(4);
    unsigned* cnt3 = (unsigned*)(ws + WS_Q + 1024);
    if (seam3_counted) {
        asm volatile("s_waitcnt vmcnt(0)" ::: "memory");
        __syncthreads();
        if (tid == 0) (void)__hip_atomic_fetch_add(cnt3 + 16 * ((int)blockIdx.x >> 3), 1u, __ATOMIC_RELAXED, __HIP_MEMORY_SCOPE_AGENT);
    } else SEAM(3);

    const bool fuse45 = (G == 256) && a.coop;
    if (IN(4)) {
        pg8::Gemm g{CC, WOUT, MTOK, DM, DM}; pg8::StaticOrder S; S.init(MTOK, DM, G, (int)blockIdx.x);
        if (seam3_counted) { pg8::Unit u0; S.next(0, u0);
            if (tid == 0) { unsigned sp = 0;
                while (__hip_atomic_load(cnt3 + 16 * u0.pm, __ATOMIC_RELAXED, __HIP_MEMORY_SCOPE_AGENT) < 8u) { __builtin_amdgcn_s_sleep(1); if (++sp > (1u << 22)) break; }
                __builtin_amdgcn_fence(__ATOMIC_ACQUIRE, "agent"); asm volatile("s_waitcnt vmcnt(0)" ::: "memory"); }
            __syncthreads(); }
        if (fuse45) {
            pg8::EpiOutFused E{a.x, a.out, mod + 4096, a.final_g, rowss, (unsigned*)(ws + WS_CNT)};
            pg8::gemm_phase<pg8::EpiOutFused, pg8::StaticOrder, false, PG8_SP2>(lds, g, S, E);
        } else {
            pg8::EpiOut E{a.x, a.out, mod + 4096, rowss};
            pg8::gemm_phase<pg8::EpiOut, pg8::StaticOrder, PG8_ALIGN, PG8_SP2>(lds, g, S, E);
        }
    }
    if (!fuse45) SEAM(4);

    if (IN(5) && !fuse45) {
        for (int m = gw; m < MTOK; m += NGW) {
            const float rstd = 1.0f / sqrtf(rowss[m] * (1.0f / DM) + EPS);
            f32x4* xr = (f32x4*)(a.out + (size_t)m * DM) + lane;
#pragma unroll
            for (int j = 0; j < 8; ++j) { const f32x4 gg = *(const f32x4*)(a.final_g + 4 * (lane + 64 * j)); xr[64 * j] = xr[64 * j] * rstd * gg; }
        }
    }
#undef IN
#undef SEAM
}

extern "C" void kernel_launch(void* const* d_in, const int* in_sizes, int n_in, void* d_out, int out_size, void* d_ws, size_t ws_size, hipStream_t stream) {
    static int grid = 0;
    if (grid == 0) {
        if (n_in != 13 || out_size != MTOK * DM || ws_size < WS_END) { fprintf(stderr, "kernel_launch: unexpected shapes (n_in %d out %d ws %zu)\n", n_in, out_size, ws_size); grid = -1; return; }
        int dev = 0, cus = 0, per_cu = 0;
        (void)hipGetDevice(&dev);
        (void)hipDeviceGetAttribute(&cus, hipDeviceAttributeMultiprocessorCount, dev);
        if (hipFuncSetAttribute((const void*)fwd_megakernel, hipFuncAttributeMaxDynamicSharedMemorySize, LDS_BYTES) != hipSuccess) { fprintf(stderr, "kernel_launch: hipFuncSetAttribute failed\n"); grid = -1; return; }
        if (hipOccupancyMaxActiveBlocksPerMultiprocessor(&per_cu, (const void*)fwd_megakernel, 512, LDS_BYTES) != hipSuccess || per_cu < 1) { fprintf(stderr, "kernel_launch: occupancy query gave %d\n", per_cu); (void)hipGetLastError(); per_cu = 1; }
        grid = cus * 1;
    }
    if (grid < 0) return;
    (void)hipMemsetAsync((char*)d_ws, 0, CTL_ZERO_BYTES, stream);
    Args a{};
    a.x = (const float*)d_in[0]; a.c = (const float*)d_in[1]; a.norm_g = (const float*)d_in[2]; a.w_ada = (const float*)d_in[3]; a.b_ada = (const float*)d_in[4];
    a.w_in = (const float*)d_in[5]; a.sinks = (const float*)d_in[6]; a.ln_g = (const float*)d_in[7]; a.ln_b = (const float*)d_in[8]; a.sgu_w = (const float*)d_in[9];
    a.sgu_b = (const float*)d_in[10]; a.w_out = (const float*)d_in[11]; a.final_g = (const float*)d_in[12];
    a.out = (float*)d_out; a.ws = (unsigned char*)d_ws; a.pad = 0;
#if MK_N_LAUNCHES == 1
    a.ph_lo = 0; a.ph_hi = 6; a.coop = 1;
    void* args[] = {&a};
    hipError_t e = hipLaunchCooperativeKernel((const void*)fwd_megakernel, dim3(grid), dim3(512), args, LDS_BYTES, stream);
    if (e != hipSuccess) fprintf(stderr, "cooperative launch failed: %s (grid %d)\n", hipGetErrorString(e), grid);
#else
    for (int p = 0; p < 6; ++p) {
        a.ph_lo = p; a.ph_hi = p + 1; a.coop = 0; a.pad = 0;
        hipLaunchKernelGGL(fwd_megakernel, dim3(grid), dim3(512), LDS_BYTES, stream, a);
#ifdef PROBE_DUP
        if (p == PROBE_DUP) { a.pad = 1; hipLaunchKernelGGL(fwd_megakernel, dim3(grid), dim3(512), LDS_BYTES, stream, a); }
#endif
    }
#endif
}
```
